# Optimizing an MI355X kernel written in HIP

```python
import jax, jax.numpy as jnp
from jax import lax
import numpy as np

D_MODEL = 2048
BATCH = 4
SEQ = 2048
DEPTH = 4

MIX_WIDTH = D_MODEL
HEAD_DIM = 128
SB_HEADS = 8
SB_WIDTH = SB_HEADS * HEAD_DIM
SB_BLOCK = 128
GLA_HEADS = 4
GLA_HEAD_V = HEAD_DIM
GLA_HEAD_K = HEAD_DIM // 2
GLA_WIDTH = GLA_HEADS * GLA_HEAD_V
GLA_KEY_WIDTH = GLA_HEADS * GLA_HEAD_K
GLA_GATE_RANK = 16
GLA_GATE_TAU = 16.0
GLA_CHUNK = 64
SGU_GROUPS = 4
SGU_WIDTH = MIX_WIDTH - SB_WIDTH - GLA_WIDTH
SGU_GROUP_DIM = SGU_WIDTH // SGU_GROUPS
SGU_CHUNK = 128
N_MIX_HEADS = MIX_WIDTH // HEAD_DIM
N_MEM = 256
XA_HEADS = 4
XA_HEAD_DIM = 128
XA_WIDTH = XA_HEADS * XA_HEAD_DIM
EPS = 1e-6

IN_SPLITS = [SB_WIDTH, SB_WIDTH, SB_WIDTH, SB_WIDTH,
             GLA_KEY_WIDTH, GLA_KEY_WIDTH, GLA_WIDTH, GLA_GATE_RANK, GLA_WIDTH,
             SGU_WIDTH, SGU_WIDTH, SGU_WIDTH]
IN_WIDTH = sum(IN_SPLITS)
IN_OFFSETS = [int(o) for o in np.cumsum(IN_SPLITS)[:-1]]

kernel_name = "hybrid_sb_gla_sgu_parallel_heads"


def rmsnorm(x, g):
    xf = x.astype(jnp.float32)
    y = xf * lax.rsqrt(jnp.mean(xf * xf, axis=-1, keepdims=True) + EPS)
    return (y * g.astype(jnp.float32)).astype(x.dtype)


def to_heads(t, n_heads):
    b, s, _ = t.shape
    return t.reshape(b, s, n_heads, -1).transpose(0, 2, 1, 3)


def from_heads(t):
    b, h, s, d = t.shape
    return t.transpose(0, 2, 1, 3).reshape(b, s, h * d)


def stick_breaking_attention(q, k, v):
    B, H, S, d = q.shape
    nblk = S // SB_BLOCK
    scale = d ** -0.5
    qb = q.reshape(B, H, nblk, SB_BLOCK, d).transpose(2, 0, 1, 3, 4)
    key_pos = jnp.arange(S)

    def block(args):
        q_blk, i = args
        z = jnp.einsum('bhqd,bhkd->bhqk', q_blk, k).astype(jnp.float32) * scale
        q_pos = i * SB_BLOCK + jnp.arange(SB_BLOCK)
        causal = key_pos[None, :] < q_pos[:, None]
        log_keep = jnp.where(causal, jax.nn.log_sigmoid(-z), 0.0)
        suffix = lax.cumsum(log_keep, axis=3, reverse=True) - log_keep
        a = jnp.where(causal, jnp.exp(jax.nn.log_sigmoid(z) + suffix), 0.0)
        return jnp.einsum('bhqk,bhkd->bhqd', a.astype(v.dtype), v)

    out = lax.map(block, (qb, jnp.arange(nblk)))
    return out.transpose(1, 2, 0, 3, 4).reshape(B, H, S, d)


def gla_chunked(q, k, v, log_alpha):
    B, H, S, dk = q.shape
    dv = v.shape[-1]
    C = GLA_CHUNK
    N = S // C
    qc = q.reshape(B, H, N, C, dk).astype(jnp.float32) * (dk ** -0.5)
    kc = k.reshape(B, H, N, C, dk).astype(jnp.float32)
    vc = v.reshape(B, H, N, C, dv).astype(jnp.float32)
    bcum = jnp.cumsum(log_alpha.reshape(B, H, N, C, dk).astype(jnp.float32), axis=3)
    tril = jnp.tril(jnp.ones((C, C), dtype=bool))
    rel = bcum[:, :, :, :, None, :] - bcum[:, :, :, None, :, :]
    decay = jnp.exp(jnp.where(tril[:, :, None], rel, -jnp.inf))
    attn = jnp.einsum('bhntd,bhnsd,bhntsd->bhnts', qc, kc, decay)
    o_intra = jnp.einsum('bhnts,bhnsv->bhntv', attn, vc)
    q_dec = qc * jnp.exp(bcum)
    b_last = bcum[:, :, :, -1:, :]
    k_dec = kc * jnp.exp(b_last - bcum)
    chunk_decay = jnp.exp(b_last[:, :, :, 0, :])
    xs = (jnp.moveaxis(q_dec, 2, 0), jnp.moveaxis(k_dec, 2, 0),
          jnp.moveaxis(vc, 2, 0), jnp.moveaxis(chunk_decay, 2, 0))

    def step(state, inp):
        qn, kn, vn, dn = inp
        o = jnp.einsum('bhtd,bhdv->bhtv', qn, state)
        state = dn[..., None] * state + jnp.einsum('bhsd,bhsv->bhdv', kn, vn)
        return state, o

    state0 = jnp.zeros((B, H, dk, dv), jnp.float32)
    _, o_inter = lax.scan(step, state0, xs)
    o = o_intra + jnp.moveaxis(o_inter, 0, 2)
    return o.reshape(B, H, S, dv).astype(v.dtype)


def chunked_sgu(u, v, g_norm, w_s, b_s):
    B, S, _ = v.shape
    N = S // SGU_CHUNK
    v = rmsnorm(v, g_norm)
    vb = v.reshape(B, N, SGU_CHUNK, SGU_GROUPS, SGU_GROUP_DIM)
    w = w_s * jnp.tril(jnp.ones((SGU_CHUNK, SGU_CHUNK), w_s.dtype))[None]
    mixed = jnp.einsum('gts,bnsgc->bntgc', w, vb) + b_s.T[None, None, :, :, None]
    return u * mixed.reshape(B, S, SGU_WIDTH)


def memory_cross_attention(h, m, w_q, w_kv, w_o):
    B, S, _ = h.shape
    q = (h @ w_q).reshape(B, S, XA_HEADS, XA_HEAD_DIM)
    k, v = jnp.split(m @ w_kv, 2, axis=-1)
    k = k.reshape(B, -1, XA_HEADS, XA_HEAD_DIM)
    v = v.reshape(B, -1, XA_HEADS, XA_HEAD_DIM)
    s = jnp.einsum('bqhd,bkhd->bhqk', q, k).astype(jnp.float32) * (XA_HEAD_DIM ** -0.5)
    p = jax.nn.softmax(s, axis=-1).astype(v.dtype)
    o = jnp.einsum('bhqk,bkhd->bqhd', p, v).reshape(B, S, XA_WIDTH)
    return o @ w_o


def setup_inputs(seed: int = 0) -> dict:
    key = jax.random.key(seed)
    ks = jax.random.split(key, 17)
    f32 = jnp.float32
    nrm = lambda k, shape, s: jax.random.normal(k, shape, f32) * s
    return {
        "x": nrm(ks[0], (BATCH, SEQ, D_MODEL), 1.0),
        "mem": nrm(ks[1], (BATCH, N_MEM, D_MODEL), 1.0),
        "norm_mix": 1.0 + nrm(ks[2], (DEPTH, D_MODEL), 0.02),
        "w_in": nrm(ks[3], (DEPTH, D_MODEL, IN_WIDTH), D_MODEL ** -0.5),
        "w_gla_gate_up": nrm(ks[4], (DEPTH, GLA_GATE_RANK, GLA_KEY_WIDTH), GLA_GATE_RANK ** -0.5),
        "b_gla_gate": nrm(ks[5], (DEPTH, GLA_KEY_WIDTH), 0.1),
        "sgu_norm": 1.0 + nrm(ks[6], (DEPTH, SGU_WIDTH), 0.02),
        "w_sgu": nrm(ks[7], (DEPTH, SGU_GROUPS, SGU_CHUNK, SGU_CHUNK), SGU_CHUNK ** -0.5),
        "b_sgu": 1.0 + nrm(ks[8], (DEPTH, SGU_GROUPS, SGU_CHUNK), 0.1),
        "out_norm": 1.0 + nrm(ks[9], (DEPTH, MIX_WIDTH), 0.02),
        "w_out": nrm(ks[10], (DEPTH, MIX_WIDTH, D_MODEL), MIX_WIDTH ** -0.5),
        "norm_xattn": 1.0 + nrm(ks[11], (DEPTH, D_MODEL), 0.02),
        "norm_mem": 1.0 + nrm(ks[12], (DEPTH, D_MODEL), 0.02),
        "w_xq": nrm(ks[13], (DEPTH, D_MODEL, XA_WIDTH), D_MODEL ** -0.5),
        "w_xkv": nrm(ks[14], (DEPTH, D_MODEL, 2 * XA_WIDTH), D_MODEL ** -0.5),
        "w_xo": nrm(ks[15], (DEPTH, XA_WIDTH, D_MODEL), XA_WIDTH ** -0.5),
        "final_norm": 1.0 + nrm(ks[16], (D_MODEL,), 0.02),
    }


def reference(x, mem, norm_mix, w_in, w_gla_gate_up, b_gla_gate, sgu_norm, w_sgu, b_sgu,
              out_norm, w_out, norm_xattn, norm_mem, w_xq, w_xkv, w_xo, final_norm):
    B, S, _ = x.shape
    for l in range(DEPTH):
        h = rmsnorm(x, norm_mix[l])
        (sb_q, sb_k, sb_v, sb_g,
         gla_q, gla_k, gla_v, gla_r, gla_g,
         sgu_u, sgu_v, sgu_g) = jnp.split(h @ w_in[l], IN_OFFSETS, axis=-1)

        o_sb = from_heads(stick_breaking_attention(
            to_heads(sb_q, SB_HEADS), to_heads(sb_k, SB_HEADS), to_heads(sb_v, SB_HEADS)))

        gate_logits = (gla_r @ w_gla_gate_up[l] + b_gla_gate[l]).astype(jnp.float32)
        log_alpha = jax.nn.log_sigmoid(gate_logits) / GLA_GATE_TAU
        o_gla = from_heads(gla_chunked(
            to_heads(gla_q, GLA_HEADS), to_heads(gla_k, GLA_HEADS),
            to_heads(gla_v, GLA_HEADS), to_heads(log_alpha, GLA_HEADS)))

        o_sgu = chunked_sgu(jax.nn.gelu(sgu_u), jax.nn.gelu(sgu_v), sgu_norm[l], w_sgu[l], b_sgu[l])

        mix = jnp.concatenate([o_sb, o_gla, o_sgu], axis=-1)
        mix = rmsnorm(mix.reshape(B, S, N_MIX_HEADS, HEAD_DIM),
                      out_norm[l].reshape(N_MIX_HEADS, HEAD_DIM)).reshape(B, S, MIX_WIDTH)
        gate = jax.nn.silu(jnp.concatenate([sb_g, gla_g, sgu_g], axis=-1))
        x = x + (mix * gate) @ w_out[l]
        x = x + memory_cross_attention(rmsnorm(x, norm_xattn[l]), rmsnorm(mem, norm_mem[l]),
                                       w_xq[l], w_xkv[l], w_xo[l])
    return rmsnorm(x, final_norm)
```

```cpp
#include <hip/hip_runtime.h>
#include <hip/hip_cooperative_groups.h>
#include <cstdio>
#include <cstdint>
namespace cg = cooperative_groups;

#ifndef MEGA
#define MEGA 1
#endif

#define LAS __attribute__((address_space(3)))
#define GAS __attribute__((address_space(1)))
typedef unsigned short bf16_t;
typedef short bf16x8 __attribute__((ext_vector_type(8)));
typedef _Float16 f16x8 __attribute__((ext_vector_type(8)));
typedef _Float16 f16x4 __attribute__((ext_vector_type(4)));
typedef float f32x4 __attribute__((ext_vector_type(4)));
typedef float f32x2_t __attribute__((ext_vector_type(2)));
typedef __bf16 bf16x2_t __attribute__((ext_vector_type(2)));
typedef unsigned u32x2 __attribute__((ext_vector_type(2)));
typedef unsigned u32x4 __attribute__((ext_vector_type(4)));

constexpr int DM = 2048, NB = 4, SEQ = 2048, DEPTH = 4, NTOK = NB * SEQ;
constexpr int INW = 7184;
constexpr int NWT = 7424;
constexpr int NMEM = 256, MEMTOK = NB * NMEM;
constexpr float EPS = 1e-6f;
constexpr int LDS_BYTES = 147456;

constexpr size_t al256(size_t x) { return (x + 255) & ~(size_t)255; }
constexpr size_t WS_WIN = 0;
constexpr size_t WS_WOUT = WS_WIN + (size_t)DEPTH * NWT * DM * 2;
constexpr size_t WS_WXQ = WS_WOUT + (size_t)DEPTH * DM * DM * 2;
constexpr size_t WS_WXKV = WS_WXQ + (size_t)DEPTH * 512 * DM * 2;
constexpr size_t WS_WXO = WS_WXKV + (size_t)DEPTH * 1024 * DM * 2;
constexpr size_t WS_MEMN = WS_WXO + (size_t)DEPTH * DM * 512 * 2;
constexpr size_t WS_KX = WS_MEMN + (size_t)DEPTH * MEMTOK * DM * 2;
constexpr size_t WS_VXT = WS_KX + (size_t)DEPTH * MEMTOK * 512 * 2;
constexpr size_t WS_X = WS_VXT + (size_t)DEPTH * MEMTOK * 512 * 2;
constexpr size_t WS_H = WS_X + (size_t)NTOK * DM * 4;
constexpr size_t WS_Q = WS_H + (size_t)NTOK * DM * 2;
constexpr size_t WS_K = WS_Q + (size_t)NTOK * 1024 * 2;
constexpr size_t WS_SBVT = WS_K + (size_t)NTOK * 1024 * 2;
constexpr size_t WS_GATE = WS_SBVT + (size_t)NTOK * 1024 * 2;
constexpr size_t WS_GLAQ = WS_GATE + (size_t)NTOK * 2048 * 2;
constexpr size_t WS_GLAK = WS_GLAQ + (size_t)NTOK * 256 * 2;
constexpr size_t WS_GLAVT = WS_GLAK + (size_t)NTOK * 256 * 2;
constexpr size_t WS_SGUU = WS_GLAVT + (size_t)NTOK * 512 * 2;
constexpr size_t WS_SGUVT = WS_SGUU + (size_t)NTOK * 512 * 2;
constexpr size_t WS_GLAR = WS_SGUVT + (size_t)NTOK * 512 * 2;
constexpr size_t WS_MIX = WS_GLAR + (size_t)NTOK * 16 * 4;
constexpr size_t WS_OINTRA = WS_MIX + (size_t)NTOK * 2048 * 2;
constexpr size_t WS_QDG = WS_OINTRA + (size_t)NTOK * 512 * 4;
constexpr size_t WS_KVT = WS_QDG + (size_t)NTOK * 256 * 2;
constexpr size_t WS_DECAY = WS_KVT + (size_t)512 * 8192 * 4;
constexpr size_t WS_SPREV = WS_DECAY + (size_t)512 * 64 * 4;
constexpr size_t WS_XQ = WS_SPREV + (size_t)512 * 8192 * 2;
constexpr size_t WS_XO = WS_XQ + (size_t)NTOK * 512 * 2;
constexpr size_t WS_SGUV = WS_XO + (size_t)NTOK * 512 * 2;
constexpr size_t WS_BAR = WS_SGUV + (size_t)NTOK * 512 * 2;
constexpr size_t WS_END = WS_BAR + 16384;

struct Params {
    const float* x; const float* mem; const float* norm_mix; const float* w_in; const float* w_up; const float* b_gate;
    const float* sgu_norm; const float* w_sgu; const float* b_sgu; const float* out_norm; const float* w_out;
    const float* norm_xattn; const float* norm_mem; const float* w_xq; const float* w_xkv; const float* w_xo; const float* final_norm;
    float* out; unsigned char* ws;
    int ph_lo, ph_hi;
};

__device__ __forceinline__ unsigned pk_bf16(float lo, float hi) { f32x2_t v = {lo, hi}; bf16x2_t b = __builtin_convertvector(v, bf16x2_t); return __builtin_bit_cast(unsigned, b); }
__device__ __forceinline__ bf16_t f2bf(float f) { unsigned u = __builtin_bit_cast(unsigned, f); return (bf16_t)((u + 0x7fffu + ((u >> 16) & 1u)) >> 16); }
__device__ __forceinline__ float bf2f(unsigned h) { return __builtin_bit_cast(float, h << 16); }
__device__ __forceinline__ float bflo(unsigned w) { return __builtin_bit_cast(float, w << 16); }
__device__ __forceinline__ float bfhi(unsigned w) { return __builtin_bit_cast(float, w & 0xffff0000u); }
typedef _Float16 f16x2_t __attribute__((ext_vector_type(2)));
__device__ __forceinline__ unsigned pk_f16(float lo, float hi) { f16x2_t h = {(_Float16)lo, (_Float16)hi}; return __builtin_bit_cast(unsigned, h); }
__device__ __forceinline__ float hflo(unsigned w) { return (float)__builtin_bit_cast(f16x2_t, w)[0]; }
__device__ __forceinline__ float hfhi(unsigned w) { return (float)__builtin_bit_cast(f16x2_t, w)[1]; }
__device__ __forceinline__ float wave_sum(float v) {
#pragma unroll
    for (int o = 1; o < 64; o <<= 1) v += __shfl_xor(v, o);
    return v;
}
__device__ __forceinline__ float silu_f(float x) { return x * __builtin_amdgcn_rcpf(1.0f + __expf(-x)); }
__device__ __forceinline__ float gelu_f(float x) {
    const float u = 0.7978845608028654f * (x + 0.044715f * x * x * x);
    return x * __builtin_amdgcn_rcpf(1.0f + __expf(-2.0f * u));
}
__device__ __forceinline__ float softplus_f(float z) { return fmaxf(z, 0.0f) + __logf(1.0f + __expf(-fabsf(z))); }
#define LDS_FENCE() asm volatile("s_waitcnt lgkmcnt(0)" ::: "memory")

template <int C8, int ROWS>
__device__ __forceinline__ void load_tile(LAS bf16_t* dst, int ldd, const GAS bf16_t* src, size_t lds_, int tid) {
    constexpr int NP = ROWS * C8 / 512;
    static_assert(ROWS * C8 % 512 == 0, "load_tile: whole pieces per thread");
    u32x4 v[NP];
#pragma unroll
    for (int i = 0; i < NP; ++i) { const int c = tid + 512 * i, r = c / C8, cc = c - r * C8; v[i] = *(const GAS u32x4*)(src + (size_t)r * lds_ + cc * 8); }
#pragma unroll
    for (int i = 0; i < NP; ++i) { const int c = tid + 512 * i, r = c / C8, cc = c - r * C8; *(LAS u32x4*)(dst + r * ldd + cc * 8) = v[i]; }
}
#define MFMA_BF16(a, b, c) __builtin_amdgcn_mfma_f32_16x16x32_bf16((a), (b), (c), 0, 0, 0)
#define MFMA_F16(a, b, c) __builtin_amdgcn_mfma_f32_16x16x32_f16((a), (b), (c), 0, 0, 0)

namespace pg8 {
constexpr int BM = 256, BK = 64, HALF = 128, HTB = HALF * BK * 2, STAGE_BYTES = 8 * HTB;
__device__ __forceinline__ int lds_byte(int r, int c) { const int st = (r >> 4) * 2 + (c >> 5), rr = r & 15, cc = c & 31, ob = rr * 64 + cc * 2; return st * 1024 + (ob ^ (((ob >> 9) & 1) << 5)); }
__device__ __forceinline__ void stage_rc(int b, int& R, int& C) { const int st = b / 1024, sb = b % 1024, swz = sb ^ (((sb >> 9) & 1) << 5); R = (st >> 1) * 16 + swz / 64; C = (st & 1) * 32 + (swz % 64) / 2; }

__device__ __forceinline__ int perm32(int rho) { const int n = rho >> 4, i = rho & 15; return 8 * (i >> 2) + 4 * n + (i & 3); }
struct Unit { void* out; const float* res; int row0, col0, ld, mode, act; float scale; };

__device__ __forceinline__ void tile_map(int L, int nM, int nN, int& pm, int& pn) {
    const int nwg = nM * nN; int wgid = L;
    { const int q = nwg / 8, r = nwg % 8, xcd = wgid % 8, off = wgid / 8; wgid = (xcd < r ? xcd * (q + 1) : r * (q + 1) + (xcd - r) * q) + off; }
    const int nig = 8 * nN, gid = wgid / nig, fm = gid * 8, gsz = (nM - fm) < 8 ? (nM - fm) : 8;
    pm = fm + ((wgid % nig) % gsz); pn = (wgid % nig) / gsz;
}

struct EpiGen {
    __device__ __forceinline__ void operator()(const f32x4 (&acc)[2][2][4][2], const Unit& u, int wr, int wc, int fr, int fq) const {
        if (u.mode == 0) {
            GAS bf16_t* O = (GAS bf16_t*)u.out;
#pragma unroll
            for (int ai = 0; ai < 2; ++ai)
#pragma unroll
                for (int m = 0; m < 4; ++m) {
                    GAS bf16_t* rp = O + (size_t)(u.row0 + ai * 128 + wr * 64 + m * 16 + fr) * u.ld + u.col0 + wc * 32 + 8 * fq;
#pragma unroll
                    for (int bj = 0; bj < 2; ++bj) {
                        f32x4 v0 = acc[ai][bj][m][0] * u.scale, v1 = acc[ai][bj][m][1] * u.scale;
                        if (u.act == 1) { v0[0] = silu_f(v0[0]); v0[1] = silu_f(v0[1]); v0[2] = silu_f(v0[2]); v0[3] = silu_f(v0[3]); v1[0] = silu_f(v1[0]); v1[1] = silu_f(v1[1]); v1[2] = silu_f(v1[2]); v1[3] = silu_f(v1[3]); }
                        else if (u.act == 2) { v0[0] = gelu_f(v0[0]); v0[1] = gelu_f(v0[1]); v0[2] = gelu_f(v0[2]); v0[3] = gelu_f(v0[3]); v1[0] = gelu_f(v1[0]); v1[1] = gelu_f(v1[1]); v1[2] = gelu_f(v1[2]); v1[3] = gelu_f(v1[3]); }
                        u32x4 w; w.x = pk_bf16(v0[0], v0[1]); w.y = pk_bf16(v0[2], v0[3]); w.z = pk_bf16(v1[0], v1[1]); w.w = pk_bf16(v1[2], v1[3]);
                        *(GAS u32x4*)(rp + bj * 128) = w;
                    }
                }
        } else if (u.mode == 1) {
            GAS bf16_t* O = (GAS bf16_t*)u.out;
#pragma unroll
            for (int ai = 0; ai < 2; ++ai)
#pragma unroll
                for (int m = 0; m < 4; ++m) {
                    const size_t off = (size_t)(u.row0 + ai * 128 + wr * 64 + m * 16 + fr) * u.ld + u.col0 + wc * 32 + 8 * fq;
#pragma unroll
                    for (int bj = 0; bj < 2; ++bj) {
                        const f32x4 v0 = acc[ai][bj][m][0], v1 = acc[ai][bj][m][1];
                        u32x4 w; w.x = pk_f16(v0[0], v0[1]); w.y = pk_f16(v0[2], v0[3]); w.z = pk_f16(v1[0], v1[1]); w.w = pk_f16(v1[2], v1[3]);
                        *(GAS u32x4*)(O + off + bj * 128) = w;
                    }
                }
        } else {
            float* O = (float*)u.out;
            if (wc == 0 && fq < 2) {
#pragma unroll
                for (int ai = 0; ai < 2; ++ai)
#pragma unroll
                    for (int m = 0; m < 4; ++m) {
                        float* rp = O + (size_t)(u.row0 + ai * 128 + wr * 64 + m * 16 + fr) * 16 + 8 * fq;
                        *(f32x4*)rp = acc[ai][0][m][0]; *(f32x4*)(rp + 4) = acc[ai][0][m][1];
                    }
            }
        }
    }
};

template <class Sched>
__device__ __forceinline__ void gemm_phase(LAS unsigned char* lds, const int K, const Sched& S) {
    const EpiGen E;
    int tid_ = threadIdx.x; asm volatile("" : "+v"(tid_));
    const int tid = tid_, wid = __builtin_amdgcn_readfirstlane(tid >> 6), lane = tid & 63, wr = wid >> 2, wc = wid & 3, fr = lane & 15, fq = lane >> 4;
    const int nt = K / BK;
    unsigned voffA[2], voffB[2];
#pragma unroll
    for (int i = 0; i < 2; ++i) { int R, C; stage_rc(tid * 16 + i * 8192, R, C); voffA[i] = (unsigned)(R * K + C) * 2u; voffB[i] = (unsigned)(((R & ~31) + perm32(R & 31)) * K + C) * 2u; }
    const size_t kstep = (size_t)(BK * 2);
    const size_t hstep = (size_t)HALF * K * 2;
    const unsigned ldsw = (unsigned)wid * 1024u;
    const int aoff = lds_byte(wr * 64 + fr, fq * 8), boff = lds_byte(wc * 32 + fr, fq * 8);
#define PG8_SA(b, h) (((b) * 2 + (h)) * HTB)
#define PG8_SB(b, h) ((4 + (b) * 2 + (h)) * HTB)
#define PG8_STAGE(bufoff, gbase, voff) do { _Pragma("unroll") for (int _i = 0; _i < 2; ++_i) \
        __builtin_amdgcn_global_load_lds((const unsigned*)((const char*)(gbase) + (voff)[_i]), (LAS unsigned*)(lds + (bufoff) + ldsw + _i * 8192), 16, 0, 0); } while (0)
#define PG8_LDA(dst, b, h) do { _Pragma("unroll") for (int m = 0; m < 4; ++m) _Pragma("unroll") for (int k = 0; k < 2; ++k) dst[m][k] = *(const LAS bf16x8*)(lds + PG8_SA(b, h) + aoff + m * 2048 + k * 1024); } while (0)
#define PG8_LDB(dst, b, h) do { _Pragma("unroll") for (int n = 0; n < 2; ++n) _Pragma("unroll") for (int k = 0; k < 2; ++k) dst[n][k] = *(const LAS bf16x8*)(lds + PG8_SB(b, h) + boff + n * 2048 + k * 1024); } while (0)
#define PG8_MMA(ai, bj, At, Bt) do { __builtin_amdgcn_s_setprio(1); _Pragma("unroll") for (int m = 0; m < 4; ++m) _Pragma("unroll") for (int n = 0; n < 2; ++n) _Pragma("unroll") for (int k = 0; k < 2; ++k) \
        acc[ai][bj][m][n] = __builtin_amdgcn_mfma_f32_16x16x32_bf16(Bt[n][k], At[m][k], acc[ai][bj][m][n], 0, 0, 0); __builtin_amdgcn_s_setprio(0); } while (0)
#define PG8_WAIT_V(n) asm volatile("s_waitcnt vmcnt(" #n ")" ::: "memory")
#define PG8_WAIT_L(n) asm volatile("s_waitcnt lgkmcnt(" #n ")" ::: "memory")
#define PG8_BAR __builtin_amdgcn_s_barrier()
#define PG8_SCHED __builtin_amdgcn_sched_barrier(0)
    int ui = 0; bool staged = false; float* st_out = nullptr; int st_row0 = 0, st_col0 = 0;
    const char* cA; const char* cB;
    if (!S.tile(0, cA, cB)) return;
    f32x4 acc[2][2][4][2];
    S.init(0, acc, wr, wc, fr, fq);
    bf16x8 At[4][2], B0[2][2], B1[2][2];
    PG8_STAGE(PG8_SB(0, 0), cB, voffB); PG8_STAGE(PG8_SB(0, 1), cB + hstep, voffB); PG8_STAGE(PG8_SA(0, 0), cA, voffA); PG8_STAGE(PG8_SA(0, 1), cA + hstep, voffA);
    if (wr == 1) PG8_BAR;
    PG8_WAIT_V(2); PG8_BAR;
    PG8_STAGE(PG8_SB(1, 0), cB + kstep, voffB); PG8_STAGE(PG8_SA(1, 0), cA + kstep, voffA); PG8_STAGE(PG8_SB(1, 1), cB + hstep + kstep, voffB);
    PG8_WAIT_V(6); PG8_BAR;
    for (;;) {
        const char* nA = cA; const char* nB = cB;
        const bool has_next = S.tile(ui + 1, nA, nB);
        for (int t = 0; t < nt; t += 2) {
            const bool last = (t == nt - 2);
            const char* a1 = cA + (size_t)(t + 1) * kstep;
            const char* a2 = last ? nA : cA + (size_t)(t + 2) * kstep; const char* b2 = last ? nB : cB + (size_t)(t + 2) * kstep;
            const char* a3 = a2 + kstep; const char* b3 = b2 + kstep;
            PG8_LDB(B0, 0, 0); PG8_LDB(B1, 0, 1); PG8_SCHED; PG8_LDA(At, 0, 0); PG8_STAGE(PG8_SA(1, 1), a1 + hstep, voffA);
            PG8_WAIT_V(8); PG8_WAIT_L(0); PG8_BAR; PG8_MMA(0, 0, At, B0); PG8_MMA(0, 1, At, B1); PG8_BAR; PG8_SCHED;
            PG8_LDA(At, 0, 1); PG8_STAGE(PG8_SB(0, 0), b2, voffB); PG8_STAGE(PG8_SB(0, 1), b2 + hstep, voffB); PG8_STAGE(PG8_SA(0, 0), a2, voffA);
            PG8_WAIT_V(8); PG8_WAIT_L(0); PG8_BAR; PG8_MMA(1, 0, At, B0); PG8_MMA(1, 1, At, B1); PG8_BAR; PG8_SCHED;
            PG8_LDB(B0, 1, 0); PG8_LDB(B1, 1, 1); PG8_SCHED; PG8_LDA(At, 1, 0); PG8_STAGE(PG8_SA(0, 1), a2 + hstep, voffA);
            PG8_WAIT_V(8); PG8_WAIT_L(0); PG8_BAR; PG8_MMA(0, 0, At, B0); PG8_MMA(0, 1, At, B1); PG8_BAR; PG8_SCHED;
            PG8_LDA(At, 1, 1); PG8_STAGE(PG8_SB(1, 0), b3, voffB); PG8_STAGE(PG8_SB(1, 1), b3 + hstep, voffB); PG8_STAGE(PG8_SA(1, 0), a3, voffA);
            PG8_WAIT_V(8); PG8_WAIT_L(0); PG8_BAR; PG8_MMA(1, 0, At, B0); PG8_MMA(1, 1, At, B1); PG8_BAR; PG8_SCHED;
        }
        if (wr == 0) PG8_BAR;
        { Unit u; S.epi(ui, u);
          if (u.mode == 1 && !has_next) { staged = true; st_out = (float*)u.out; st_row0 = u.row0; st_col0 = u.col0; }
          else E(acc, u, wr, wc, fr, fq); }
        if (!has_next) break;
        S.init(ui + 1, acc, wr, wc, fr, fq);
        cA = nA; cB = nB; ++ui;
        if (wr == 1) PG8_BAR;
    }
    PG8_WAIT_V(0);
    PG8_BAR;
    if (staged) {
        LAS float* Sg = (LAS float*)lds;
        GAS bf16_t* O = (GAS bf16_t*)st_out;
#pragma unroll
        for (int ai = 0; ai < 2; ++ai) {
#pragma unroll
            for (int m = 0; m < 4; ++m)
#pragma unroll
                for (int bj = 0; bj < 2; ++bj)
#pragma unroll
                    for (int n = 0; n < 2; ++n) *(LAS f32x4*)(Sg + (wr * 64 + m * 16 + fr) * 260 + bj * 128 + wc * 32 + 8 * fq + 4 * n) = acc[ai][bj][m][n];
            __syncthreads();
#pragma unroll
            for (int r = 0; r < 16; ++r) {
                const int rl = wid * 16 + r;
                const f32x4 v = *(const LAS f32x4*)(Sg + rl * 260 + lane * 4);
                { u32x2 w; w.x = pk_f16(v[0], v[1]); w.y = pk_f16(v[2], v[3]); *(GAS u32x2*)(O + (size_t)(st_row0 + ai * 128 + rl) * 2048 + st_col0 + lane * 4) = w; }
            }
            __syncthreads();
        }
    }
#undef PG8_SA
#undef PG8_SB
#undef PG8_STAGE
#undef PG8_LDA
#undef PG8_LDB
#undef PG8_MMA
#undef PG8_WAIT_V
#undef PG8_WAIT_L
#undef PG8_BAR
#undef PG8_SCHED
}
}
using pg8::Unit;

struct SchedIn {
    const unsigned char* ws; int l, G, c;
    __device__ __forceinline__ bool tile(int i, const char*& a, const char*& b) const {
        int L = i * G + c; if (L >= 1008) return false;
        const char* h = (const char*)(ws + WS_H); const char* w = (const char*)(ws + WS_WIN) + (size_t)l * NWT * DM * 2;
        const size_t tstep = (size_t)256 * DM * 2; int pm, pn;
        if (L < 736) { pg8::tile_map(L, 32, 23, pm, pn); a = h + pm * tstep; b = (pn < 21) ? w + pn * tstep : w + (size_t)(6912 + (pn - 21) * 256) * DM * 2; }
        else if (L < 992) { pg8::tile_map(L - 736, 8, 32, pm, pn); a = w + (size_t)(5376 + pm * 256) * DM * 2; b = h + pn * tstep; }
        else {
            const int r = L - 992;
            const char* mn = (const char*)(ws + WS_MEMN) + (size_t)l * MEMTOK * DM * 2; const char* wk = (const char*)(ws + WS_WXKV) + (size_t)l * 1024 * DM * 2;
            if (r < 8) { pm = r >> 1; pn = r & 1; a = mn + pm * tstep; b = wk + pn * tstep; }
            else { const int r8 = r - 8; pm = r8 >> 2; pn = r8 & 3; a = wk + (size_t)(512 + pm * 256) * DM * 2; b = mn + pn * tstep; }
        }
        return true;
    }
    __device__ __forceinline__ void epi(int i, Unit& u) const {
        int L = i * G + c; int pm, pn;
        u.res = nullptr; u.mode = 0; u.act = 0; u.scale = 1.0f;
        if (L < 736) {
            pg8::tile_map(L, 32, 23, pm, pn); u.row0 = pm * 256;
            if (pn < 4)        { u.out = (void*)(ws + WS_Q); u.ld = 1024; u.col0 = pn * 256; u.scale = 0.08838834764831845f * 1.4426950408889634f; }
            else if (pn < 8)   { u.out = (void*)(ws + WS_K); u.ld = 1024; u.col0 = (pn - 4) * 256; }
            else if (pn < 16)  { u.out = (void*)(ws + WS_GATE); u.ld = 2048; u.col0 = (pn - 8) * 256; u.act = 1; }
            else if (pn == 16) { u.out = (void*)(ws + WS_GLAQ); u.ld = 256; u.col0 = 0; u.scale = 0.125f; }
            else if (pn == 17) { u.out = (void*)(ws + WS_GLAK); u.ld = 256; u.col0 = 0; }
            else if (pn < 20)  { u.out = (void*)(ws + WS_SGUU); u.ld = 512; u.col0 = (pn - 18) * 256; u.act = 2; }
            else if (pn == 20) { u.out = (void*)(ws + WS_GLAR); u.ld = 16; u.col0 = 0; u.mode = 2; }
            else               { u.out = (void*)(ws + WS_SGUV); u.ld = 512; u.col0 = (pn - 21) * 256; u.act = 2; }
        } else if (L < 992) {
            pg8::tile_map(L - 736, 8, 32, pm, pn);
            const int b = pn >> 3; u.col0 = (pn & 7) * 256; u.ld = 2048;
            if (pm < 4)      { u.out = (void*)(ws + WS_SBVT); u.row0 = b * 1024 + pm * 256; }
            else if (pm < 6) { u.out = (void*)(ws + WS_GLAVT); u.row0 = b * 512 + (pm - 4) * 256; }
            else             { u.out = (void*)(ws + WS_SGUVT); u.row0 = b * 512 + (pm - 6) * 256; u.act = 2; }
        } else {
            const int r = L - 992;
            if (r < 8) { pm = r >> 1; pn = r & 1; u.out = (void*)(ws + WS_KX + (size_t)l * MEMTOK * 512 * 2); u.row0 = pm * 256; u.col0 = pn * 256; u.ld = 512; }
            else { const int r8 = r - 8; pm = r8 >> 2; pn = r8 & 3;
                u.out = (void*)(ws + WS_VXT + (size_t)l * MEMTOK * 512 * 2); u.row0 = pn * 512 + pm * 256; u.col0 = 0; u.ld = 256; }
        }
    }
};
struct SchedOut {
    const unsigned char* ws; const float* xin; int l, G, c;
    __device__ __forceinline__ bool tile(int i, const char*& a, const char*& b) const {
        const int L = i * G + c; if (L >= 256) return false;
        int pm, pn; pg8::tile_map(L, 32, 8, pm, pn);
        const size_t tstep = (size_t)256 * DM * 2;
        a = (const char*)(ws + WS_MIX) + pm * tstep; b = (const char*)(ws + WS_WOUT) + (size_t)l * DM * DM * 2 + pn * tstep;
        return true;
    }
    __device__ __forceinline__ void epi(int i, Unit& u) const {
        const int L = i * G + c; int pm, pn; pg8::tile_map(L, 32, 8, pm, pn);
        u.out = (void*)(ws + WS_X); u.res = xin; u.row0 = pm * 256; u.col0 = pn * 256; u.ld = 2048; u.mode = 1; u.act = 0; u.scale = 1.0f;
    }
};
struct SchedXo {
    const unsigned char* ws; int l, G, c;
    __device__ __forceinline__ bool tile(int i, const char*& a, const char*& b) const {
        const int L = i * G + c; if (L >= 256) return false;
        int pm, pn; pg8::tile_map(L, 32, 8, pm, pn);
        const size_t tstep = (size_t)256 * 512 * 2;
        a = (const char*)(ws + WS_XO) + pm * tstep; b = (const char*)(ws + WS_WXO) + (size_t)l * DM * 512 * 2 + pn * tstep;
        return true;
    }
    __device__ __forceinline__ void epi(int i, Unit& u) const {
        const int L = i * G + c; int pm, pn; pg8::tile_map(L, 32, 8, pm, pn);
        u.out = (void*)(ws + WS_X); u.res = (const float*)(const void*)(ws + WS_X); u.row0 = pm * 256; u.col0 = pn * 256; u.ld = 2048; u.mode = 1; u.act = 0; u.scale = 1.0f;
    }
};

struct SchedAny {
    const unsigned char* ws; const float* xin; int l, G, c, kind;
    __device__ __forceinline__ bool tile(int i, const char*& a, const char*& b) const {
        if (kind == 0) { SchedIn S{ws, l, G, c}; return S.tile(i, a, b); }
        if (kind == 1) { SchedOut S{ws, xin, l, G, c}; return S.tile(i, a, b); }
        SchedXo S{ws, l, G, c}; return S.tile(i, a, b);
    }
    __device__ __forceinline__ void init(int i, f32x4 (&acc)[2][2][4][2], int wr, int wc, int fr, int fq) const {
        if (kind == 0) {
#pragma unroll
            for (int a = 0; a < 2; ++a)
#pragma unroll
                for (int b = 0; b < 2; ++b)
#pragma unroll
                    for (int m = 0; m < 4; ++m)
#pragma unroll
                        for (int n = 0; n < 2; ++n) acc[a][b][m][n] = (f32x4){0.f, 0.f, 0.f, 0.f};
        } else {
            const int L = i * G + c; if (L >= 256) return;
            int pm, pn; pg8::tile_map(L, 32, 8, pm, pn);
            if (kind == 1 && l == 0) {
                const GAS float* R = (const GAS float*)xin;
#pragma unroll
                for (int a = 0; a < 2; ++a)
#pragma unroll
                    for (int m = 0; m < 4; ++m) {
                        const size_t off = (size_t)(pm * 256 + a * 128 + wr * 64 + m * 16 + fr) * 2048 + pn * 256 + wc * 32 + 8 * fq;
#pragma unroll
                        for (int b = 0; b < 2; ++b)
#pragma unroll
                            for (int n = 0; n < 2; ++n) acc[a][b][m][n] = *(const GAS f32x4*)(R + off + b * 128 + n * 4);
                    }
            } else {
                const GAS bf16_t* R = (const GAS bf16_t*)(ws + WS_X);
#pragma unroll
                for (int a = 0; a < 2; ++a)
#pragma unroll
                    for (int m = 0; m < 4; ++m) {
                        const size_t off = (size_t)(pm * 256 + a * 128 + wr * 64 + m * 16 + fr) * 2048 + pn * 256 + wc * 32 + 8 * fq;
#pragma unroll
                        for (int b = 0; b < 2; ++b) {
                            const u32x4 w = *(const GAS u32x4*)(R + off + b * 128);
                            acc[a][b][m][0] = (f32x4){hflo(w.x), hfhi(w.x), hflo(w.y), hfhi(w.y)};
                            acc[a][b][m][1] = (f32x4){hflo(w.z), hfhi(w.z), hflo(w.w), hfhi(w.w)};
                        }
                    }
            }
        }
    }
    __device__ __forceinline__ void epi(int i, Unit& u) const {
        if (kind == 0) { SchedIn S{ws, l, G, c}; S.epi(i, u); }
        else if (kind == 1) { SchedOut S{ws, xin, l, G, c}; S.epi(i, u); }
        else { SchedXo S{ws, l, G, c}; S.epi(i, u); }
    }
};

template <bool F32OUT, bool SRCBF = false>
__device__ __forceinline__ void norm_rows(const GAS void* srcv, const float* g, GAS void* dst, int nrows, int gw, int nw, int lane) {
    for (int row0 = gw; row0 < nrows; row0 += 4 * nw) {
        f32x4 v[4][8], gv[8]; float ss[4];
#pragma unroll
        for (int q = 0; q < 4; ++q) {
            const int row = row0 + q * nw; const size_t ro = (size_t)(row < nrows ? row : row0) * DM;
            if (SRCBF) { const GAS u32x2* s2 = (const GAS u32x2*)((const GAS bf16_t*)srcv + ro);
#pragma unroll
                for (int i = 0; i < 8; ++i) { const u32x2 w = s2[lane + 64 * i]; v[q][i] = (f32x4){hflo(w.x), hfhi(w.x), hflo(w.y), hfhi(w.y)}; } }
            else { const GAS f32x4* s4 = (const GAS f32x4*)((const GAS float*)srcv + ro);
#pragma unroll
                for (int i = 0; i < 8; ++i) v[q][i] = s4[lane + 64 * i]; }
        }
#pragma unroll
        for (int i = 0; i < 8; ++i) gv[i] = ((const f32x4*)g)[lane + 64 * i];
#pragma unroll
        for (int q = 0; q < 4; ++q) {
            float a = 0.f;
#pragma unroll
            for (int i = 0; i < 8; ++i) a += v[q][i][0] * v[q][i][0] + v[q][i][1] * v[q][i][1] + v[q][i][2] * v[q][i][2] + v[q][i][3] * v[q][i][3];
            ss[q] = 1.0f / sqrtf(wave_sum(a) * (1.0f / DM) + EPS);
        }
#pragma unroll
        for (int q = 0; q < 4; ++q) {
            const int row = row0 + q * nw;
            if (row < nrows) {
#pragma unroll
                for (int i = 0; i < 8; ++i) {
                    const f32x4 y = v[q][i] * ss[q] * gv[i];
                    if (F32OUT) ((GAS f32x4*)((GAS float*)dst + (size_t)row * DM))[lane + 64 * i] = y;
                    else { u32x2 w; w.x = pk_bf16(y[0], y[1]); w.y = pk_bf16(y[2], y[3]); ((GAS u32x2*)((GAS bf16_t*)dst + (size_t)row * DM))[lane + 64 * i] = w; }
                }
            }
        }
    }
}

__device__ __forceinline__ int win_src_col(int n) {
    if (n < 2048) return n;
    if (n < 3072) return 3072 + (n - 2048);
    if (n < 3584) return 5136 + (n - 3072);
    if (n < 4096) return 6672 + (n - 3584);
    if (n < 4608) return n;
    if (n < 5120) return 5648 + (n - 4608);
    if (n < 5136) return n;
    if (n < 5376) return -1;
    if (n < 6400) return 2048 + (n - 5376);
    if (n < 6912) return 4608 + (n - 6400);
    return 6160 + (n - 6912);
}
struct TDesc { const float* src; GAS bf16_t* dst; const float* gain; int K, N, k0, n0; bool winmap, f16; };
__device__ __forceinline__ TDesc tdesc(const Params& p, int t) {
    constexpr int T_IN = 32 * 58, T_OUT = 32 * 16, T_XQ = 32 * 4, T_XKV = 32 * 8, T_XO = 8 * 16, T_L = T_IN + T_OUT + T_XQ + T_XKV + T_XO;
    unsigned char* ws = p.ws; TDesc d;
    const int l = t / T_L; int r = t - l * T_L;
    if (r < T_IN) { d.src = p.w_in + (size_t)l * DM * INW; d.dst = (GAS bf16_t*)(ws + WS_WIN) + (size_t)l * NWT * DM; d.K = DM; d.N = INW; d.k0 = (r & 31) * 64; d.n0 = (r >> 5) * 128; d.winmap = true; d.gain = nullptr; d.f16 = false; return d; }
    r -= T_IN; d.winmap = false; d.gain = nullptr; d.f16 = false;
    if (r < T_OUT) { d.src = p.w_out + (size_t)l * DM * DM; d.dst = (GAS bf16_t*)(ws + WS_WOUT) + (size_t)l * DM * DM; d.K = DM; d.N = DM; d.k0 = (r & 31) * 64; d.n0 = (r >> 5) * 128; return d; }
    r -= T_OUT;
    if (r < T_XQ) { d.src = p.w_xq + (size_t)l * DM * 512; d.dst = (GAS bf16_t*)(ws + WS_WXQ) + (size_t)l * 512 * DM; d.K = DM; d.N = 512; d.k0 = (r & 31) * 64; d.n0 = (r >> 5) * 128; d.gain = p.norm_xattn + (size_t)l * DM; d.f16 = true; return d; }
    r -= T_XQ;
    if (r < T_XKV) { d.src = p.w_xkv + (size_t)l * DM * 1024; d.dst = (GAS bf16_t*)(ws + WS_WXKV) + (size_t)l * 1024 * DM; d.K = DM; d.N = 1024; d.k0 = (r & 31) * 64; d.n0 = (r >> 5) * 128; return d; }
    r -= T_XKV;
    d.src = p.w_xo + (size_t)l * 512 * DM; d.dst = (GAS bf16_t*)(ws + WS_WXO) + (size_t)l * DM * 512; d.K = 512; d.N = DM; d.k0 = (r & 7) * 64; d.n0 = (r >> 3) * 128; return d;
}
__device__ __forceinline__ void tload(const TDesc& d, float (&v)[2][8], int tid) {
    const int nn = tid & 63, kq = tid >> 6;
#pragma unroll
    for (int h = 0; h < 2; ++h) {
        const int n = d.n0 + 64 * h + nn; const int sc = d.winmap ? win_src_col(n) : n;
        const float* sp = d.src + (size_t)(d.k0 + kq * 8) * d.N + (sc >= 0 ? sc : 0);
#pragma unroll
        for (int i = 0; i < 8; ++i) v[h][i] = sp[(size_t)i * d.N];
    }
}
__device__ void prologue(const Params& p, LAS unsigned char* lds, const int bid, const int nblk) {
    int tid_ = threadIdx.x; asm volatile("" : "+v"(tid_));
    const int tid = tid_, lane = tid & 63, wid = tid >> 6;
    unsigned char* ws = p.ws;
    LAS float* T = (LAS float*)lds;
    constexpr int T_ALL = DEPTH * (32 * 58 + 32 * 16 + 32 * 4 + 32 * 8 + 8 * 16);
    float v[2][8];
    int t = bid;
    if (t < T_ALL) { const TDesc d = tdesc(p, t); tload(d, v, tid); }
    for (; t < T_ALL; t += nblk) {
        const TDesc d = tdesc(p, t);
        __syncthreads();
        { const int nn = tid & 63, kq = tid >> 6;
          float gk[8];
#pragma unroll
          for (int i = 0; i < 8; ++i) gk[i] = d.gain ? d.gain[d.k0 + kq * 8 + i] : 1.0f;
#pragma unroll
          for (int h = 0; h < 2; ++h)
#pragma unroll
            for (int i = 0; i < 8; ++i) { const int n = d.n0 + 64 * h + nn; const bool pad = d.winmap && n >= 5136 && n < 5376; T[h * 4160 + (kq * 8 + i) * 65 + nn] = pad ? 0.0f : v[h][i] * gk[i]; } }
        __syncthreads();
        if (t + nblk < T_ALL) { const TDesc dn = tdesc(p, t + nblk); tload(dn, v, tid); }
        { const int n = tid >> 3, kc = tid & 7;
#pragma unroll
          for (int h = 0; h < 2; ++h) {
            float x[8];
#pragma unroll
            for (int e = 0; e < 8; ++e) x[e] = T[h * 4160 + (kc * 8 + e) * 65 + n];
            u32x4 w;
            if (d.f16) { w.x = pk_f16(x[0], x[1]); w.y = pk_f16(x[2], x[3]); w.z = pk_f16(x[4], x[5]); w.w = pk_f16(x[6], x[7]); }
            else { w.x = pk_bf16(x[0], x[1]); w.y = pk_bf16(x[2], x[3]); w.z = pk_bf16(x[4], x[5]); w.w = pk_bf16(x[6], x[7]); }
            *(u32x4*)(d.dst + (size_t)(d.n0 + 64 * h + n) * d.K + d.k0 + kc * 8) = w;
          } }
    }
    const int gw = bid * 8 + wid, nw = nblk * 8;
    for (int l = 0; l < DEPTH; ++l) norm_rows<false>((const GAS void*)p.mem, p.norm_mem + l * DM, (GAS bf16_t*)(ws + WS_MEMN) + (size_t)l * MEMTOK * DM, MEMTOK, gw, nw, lane);
    norm_rows<false>((const GAS void*)p.x, p.norm_mix, (GAS bf16_t*)(ws + WS_H), NTOK, gw, nw, lane);
}

__device__ __forceinline__ void finish_head(const Params& p, int l, const f32x4 (&o)[8], size_t tok, int colbase, int fq) {
    float ss = 0.f;
#pragma unroll
    for (int n = 0; n < 8; ++n) ss += o[n][0] * o[n][0] + o[n][1] * o[n][1] + o[n][2] * o[n][2] + o[n][3] * o[n][3];
    ss += __shfl_xor(ss, 16); ss += __shfl_xor(ss, 32);
    const float rstd = 1.0f / sqrtf(ss * (1.0f / 128.0f) + EPS);
    const float* gn = p.out_norm + (size_t)l * 2048 + colbase + 4 * fq;
    const GAS bf16_t* gt = (const GAS bf16_t*)(p.ws + WS_GATE) + tok * 2048 + colbase + 4 * fq;
    GAS bf16_t* mx = (GAS bf16_t*)(p.ws + WS_MIX) + tok * 2048 + colbase + 4 * fq;
    f32x4 gv[8]; u32x2 gtv[8];
#pragma unroll
    for (int n = 0; n < 8; ++n) { gv[n] = *(const f32x4*)(gn + 16 * n); gtv[n] = *(const u32x2*)(gt + 16 * n); }
#pragma unroll
    for (int n = 0; n < 8; ++n) {
        const f32x4 g = gv[n]; const u32x2 gg = gtv[n];
        const float y0 = bf2f(pk_bf16(o[n][0] * rstd * g[0], 0.f) & 0xffffu) * bflo(gg.x);
        const float y1 = bf2f(pk_bf16(o[n][1] * rstd * g[1], 0.f) & 0xffffu) * bfhi(gg.x);
        const float y2 = bf2f(pk_bf16(o[n][2] * rstd * g[2], 0.f) & 0xffffu) * bflo(gg.y);
        const float y3 = bf2f(pk_bf16(o[n][3] * rstd * g[3], 0.f) & 0xffffu) * bfhi(gg.y);
        u32x2 w; w.x = pk_bf16(y0, y1); w.y = pk_bf16(y2, y3);
        *(u32x2*)(mx + 16 * n) = w;
    }
}

template <bool DIAG>
__device__ __forceinline__ void sb_step(f32x4 (&o)[8], float& R, const LAS bf16_t* Qs, const LAS bf16_t* Ks, const LAS bf16_t* Vs, LAS bf16_t* Ps,
                                        const f16x8& U0, const f16x8& U16, int qloc, int fr, int fq) {
    f32x4 z[8];
#pragma unroll
    for (int n = 0; n < 8; ++n) z[n] = (f32x4){0.f, 0.f, 0.f, 0.f};
    __builtin_amdgcn_s_setprio(1);
#pragma unroll
    for (int kk = 0; kk < 4; ++kk) {
        const bf16x8 qa = *(const LAS bf16x8*)(Qs + fr * 136 + kk * 32 + fq * 8);
#pragma unroll
        for (int n = 0; n < 8; ++n) { const bf16x8 kf = *(const LAS bf16x8*)(Ks + (n * 16 + fr) * 136 + kk * 32 + fq * 8); z[n] = MFMA_BF16(kf, qa, z[n]); }
        __builtin_amdgcn_sched_barrier(0);
    }
    __builtin_amdgcn_s_setprio(0);
    float rs = 0.f;
#pragma unroll
    for (int n = 0; n < 8; ++n) {
        f16x4 hv;
#pragma unroll
        for (int r = 0; r < 4; ++r) {
            const float zz = z[n][r];
            float lk = -(fmaxf(zz, 0.0f) + __builtin_amdgcn_logf(1.0f + __builtin_amdgcn_exp2f(-fabsf(zz))));
            if (DIAG) lk = (n * 16 + 4 * fq + r < qloc) ? lk : 0.0f;
            z[n][r] = zz + lk;
            rs += lk; hv[r] = (_Float16)lk;
        }
        *(LAS f16x4*)(Ps + fr * 136 + n * 16 + 4 * fq) = hv;
    }
    rs += __shfl_xor(rs, 16); rs += __shfl_xor(rs, 32);
    LDS_FENCE();
    f16x8 ONES;
#pragma unroll
    for (int e = 0; e < 8; ++e) ONES[e] = (_Float16)1.0f;
#pragma unroll
    for (int kk = 0; kk < 4; ++kk) {
        const f16x8 pa = *(const LAS f16x8*)(Ps + fr * 136 + kk * 32 + fq * 8);
#pragma unroll
        for (int n = 0; n < 8; ++n) {
            const int dl = 32 * kk - 16 * n;
            if (dl >= 16) z[n] = MFMA_F16(ONES, pa, z[n]);
            else if (dl == 0) z[n] = MFMA_F16(U0, pa, z[n]);
            else if (dl == -16) z[n] = MFMA_F16(U16, pa, z[n]);
        }
    }
#pragma unroll
    for (int n = 0; n < 8; ++n) {
        float a[4];
#pragma unroll
        for (int r = 0; r < 4; ++r) {
            a[r] = __builtin_amdgcn_exp2f(z[n][r] + R);
            if (DIAG) a[r] = (n * 16 + 4 * fq + r < qloc) ? a[r] : 0.0f;
        }
        u32x2 w; w.x = pk_bf16(a[0], a[1]); w.y = pk_bf16(a[2], a[3]);
        *(LAS u32x2*)(Ps + fr * 136 + n * 16 + 4 * fq) = w;
    }
    R += rs;
    LDS_FENCE();
    __builtin_amdgcn_s_setprio(1);
#pragma unroll
    for (int kk = 0; kk < 4; ++kk) {
        const bf16x8 pa = *(const LAS bf16x8*)(Ps + fr * 136 + kk * 32 + fq * 8);
#pragma unroll
        for (int n = 0; n < 8; ++n) { const bf16x8 vf = *(const LAS bf16x8*)(Vs + (n * 16 + fr) * 136 + kk * 32 + fq * 8); o[n] = MFMA_BF16(vf, pa, o[n]); }
        __builtin_amdgcn_sched_barrier(0);
    }
    __builtin_amdgcn_s_setprio(0);
}
__device__ void sb_phase(const Params& p, int l, LAS unsigned char* lds, const int bid, const int nblk) {
    int tid_ = threadIdx.x; asm volatile("" : "+v"(tid_));
    const int tid = tid_, wid = __builtin_amdgcn_readfirstlane(tid >> 6), lane = tid & 63, fr = lane & 15, fq = lane >> 4;
    LAS bf16_t* Ks = (LAS bf16_t*)lds;
    LAS bf16_t* Vs = Ks + 128 * 136;
    LAS bf16_t* Ps = Vs + 128 * 136 + wid * 16 * 136;
    LAS bf16_t* Qs = Vs + 2 * 128 * 136 + wid * 16 * 136;
    const GAS bf16_t* qb = (const GAS bf16_t*)(p.ws + WS_Q); const GAS bf16_t* kb = (const GAS bf16_t*)(p.ws + WS_K); const GAS bf16_t* vt = (const GAS bf16_t*)(p.ws + WS_SBVT);
    f16x8 U0, U16;
#pragma unroll
    for (int e = 0; e < 8; ++e) { U0[e] = (8 * fq + e - fr > 0) ? (_Float16)1.0f : (_Float16)0.0f; U16[e] = (8 * fq + e - fr > 16) ? (_Float16)1.0f : (_Float16)0.0f; }
    const int lr = tid >> 4, lc = (tid & 15) * 8;
    for (int pr = bid; pr < 256; pr += nblk) {
        const int bh = pr >> 3, ip = pr & 7, b = bh >> 3, h = bh & 7;
        const GAS bf16_t* kbase = kb + ((size_t)b * SEQ + lr) * 1024 + h * 128 + lc;
        const GAS bf16_t* vbase = vt + ((size_t)(b * 8 + h) * 128 + lr) * SEQ + lc;
        for (int half = 0; half < 2; ++half) {
            const int qi = half ? 15 - ip : ip;
            const int qloc = wid * 16 + fr;
            const size_t tok = (size_t)b * SEQ + qi * 128 + qloc;
            u32x4 pk[4], pv[4];
#pragma unroll
            for (int i = 0; i < 4; ++i) { pk[i] = *(const u32x4*)(kbase + ((size_t)qi * 128 + 32 * i) * 1024); pv[i] = *(const u32x4*)(vbase + (size_t)(32 * i) * SEQ + qi * 128); }
#pragma unroll
            for (int kk = 0; kk < 4; ++kk) *(LAS bf16x8*)(Qs + fr * 136 + kk * 32 + fq * 8) = *(const bf16x8*)(qb + tok * 1024 + h * 128 + kk * 32 + fq * 8);
            f32x4 o[8];
#pragma unroll
            for (int n = 0; n < 8; ++n) o[n] = (f32x4){0.f, 0.f, 0.f, 0.f};
            float R = 0.f;
            for (int j = qi; j >= 0; --j) {
                __syncthreads();
#pragma unroll
                for (int i = 0; i < 4; ++i) { *(LAS u32x4*)(Ks + (lr + 32 * i) * 136 + lc) = pk[i]; *(LAS u32x4*)(Vs + (lr + 32 * i) * 136 + lc) = pv[i]; }
                __syncthreads();
                if (j > 0) {
#pragma unroll
                    for (int i = 0; i < 4; ++i) { pk[i] = *(const u32x4*)(kbase + ((size_t)(j - 1) * 128 + 32 * i) * 1024); pv[i] = *(const u32x4*)(vbase + (size_t)(32 * i) * SEQ + (j - 1) * 128); }
                }
                if (j == qi) sb_step<true>(o, R, Qs, Ks, Vs, Ps, U0, U16, qloc, fr, fq);
                else sb_step<false>(o, R, Qs, Ks, Vs, Ps, U0, U16, qloc, fr, fq);
            }
            finish_head(p, l, o, tok, h * 128, fq);
        }
    }
}

__device__ void gla_p1(const Params& p, int l, LAS unsigned char* lds, const int bid, const int nblk) {
    int tid_ = threadIdx.x; asm volatile("" : "+v"(tid_));
    const int tid = tid_, wid = __builtin_amdgcn_readfirstlane(tid >> 6), lane = tid & 63, fr = lane & 15, fq = lane >> 4;
    LAS bf16_t* qd = (LAS bf16_t*)lds;
    LAS bf16_t* ki = qd + 128 * 72;
    LAS bf16_t* kdT = ki + 128 * 72;
    LAS bf16_t* vT = kdT + 2 * 64 * 72;
    LAS bf16_t* Am = vT + 128 * 136;
    LAS float* gtot = (LAS float*)(Am + 128 * 72);
    LAS float* gr = gtot + 512;
    unsigned char* ws = p.ws;
    const GAS bf16_t* glaq = (const GAS bf16_t*)(ws + WS_GLAQ); const GAS bf16_t* glak = (const GAS bf16_t*)(ws + WS_GLAK); const GAS bf16_t* glavT = (const GAS bf16_t*)(ws + WS_GLAVT);
    const GAS float* glar = (const GAS float*)(ws + WS_GLAR);
    GAS bf16_t* qdg = (GAS bf16_t*)(ws + WS_QDG); GAS float* ointra = (GAS float*)(ws + WS_OINTRA); GAS float* kvt = (GAS float*)(ws + WS_KVT); GAS float* decay = (GAS float*)(ws + WS_DECAY);
    for (int it = bid; it < 256; it += nblk) {
        const int bh = it >> 4, cp = it & 15, b = bh >> 2, h = bh & 3;
        const size_t T0 = (size_t)b * SEQ + cp * 128;
        __syncthreads();
        { const f32x4 g4 = *(const f32x4*)(glar + T0 * 16 + tid * 4); *(LAS f32x4*)(gr + tid * 4) = g4; }
        load_tile<16, 128>(vT, 136, glavT + ((size_t)(b * 4 + h) * 128) * SEQ + cp * 128, SEQ, tid);
        const int d = tid & 63, tg = wid;
        float wu[16];
#pragma unroll
        for (int r = 0; r < 16; ++r) wu[r] = p.w_up[((size_t)l * 16 + r) * 256 + h * 64 + d];
        const float bias = p.b_gate[l * 256 + h * 64 + d];
        load_tile<8, 128>(qd, 72, glaq + T0 * 256 + h * 64, 256, tid);
        load_tile<8, 128>(ki, 72, glak + T0 * 256 + h * 64, 256, tid);
        __syncthreads();
        float cs[16]; float run = 0.f;
#pragma unroll
        for (int i = 0; i < 16; ++i) {
            const LAS f32x4* rr = (const LAS f32x4*)(gr + (tg * 16 + i) * 16);
            float lg = bias;
#pragma unroll
            for (int r4 = 0; r4 < 4; ++r4) { const f32x4 q4 = rr[r4]; lg += q4[0] * wu[4 * r4] + q4[1] * wu[4 * r4 + 1] + q4[2] * wu[4 * r4 + 2] + q4[3] * wu[4 * r4 + 3]; }
            run += -softplus_f(-lg) * (1.0f / 16.0f);
            cs[i] = run;
        }
        gtot[tg * 64 + d] = run;
        __syncthreads();
        const int c = tg >> 2; float off = 0.f, bl = 0.f;
#pragma unroll
        for (int g = 0; g < 4; ++g) { const float t = gtot[(c * 4 + g) * 64 + d]; bl += t; if (c * 4 + g < tg) off += t; }
#pragma unroll
        for (int i = 0; i < 16; ++i) {
            const int t = tg * 16 + i; const size_t tok = T0 + t;
            const float bc = cs[i] + off;
            const float q = bf2f(qd[t * 72 + d]), k = bf2f(ki[t * 72 + d]);
            const bf16_t qv = f2bf(q * __expf(bc));
            qd[t * 72 + d] = qv; qdg[tok * 256 + h * 64 + d] = qv;
            ki[t * 72 + d] = f2bf(k * __expf(-bc));
            kdT[(c * 64 + d) * 72 + (t & 63)] = f2bf(k * __expf(bl - bc));
        }
        if ((tg & 3) == 0) decay[((size_t)bh * 32 + cp * 2 + c) * 64 + d] = __expf(bl);
        __syncthreads();
        const int lr0 = (wid & 3) * 16, trw = c * 64 + lr0 + fr;
        f32x4 a4[4];
#pragma unroll
        for (int n = 0; n < 4; ++n) a4[n] = (f32x4){0.f, 0.f, 0.f, 0.f};
#pragma unroll
        for (int kk = 0; kk < 2; ++kk) {
            const bf16x8 qa = *(const LAS bf16x8*)(qd + trw * 72 + kk * 32 + fq * 8);
#pragma unroll
            for (int n = 0; n < 4; ++n) { const bf16x8 kf = *(const LAS bf16x8*)(ki + (c * 64 + n * 16 + fr) * 72 + kk * 32 + fq * 8); a4[n] = MFMA_BF16(kf, qa, a4[n]); }
        }
#pragma unroll
        for (int n = 0; n < 4; ++n) {
            float a[4];
#pragma unroll
            for (int r = 0; r < 4; ++r) a[r] = (n * 16 + 4 * fq + r <= lr0 + fr) ? a4[n][r] : 0.0f;
            u32x2 w; w.x = pk_bf16(a[0], a[1]); w.y = pk_bf16(a[2], a[3]);
            *(LAS u32x2*)(Am + trw * 72 + n * 16 + 4 * fq) = w;
        }
        LDS_FENCE();
        {
            f32x4 o[8];
#pragma unroll
            for (int n = 0; n < 8; ++n) o[n] = (f32x4){0.f, 0.f, 0.f, 0.f};
#pragma unroll
            for (int kk = 0; kk < 2; ++kk) {
                const bf16x8 pa = *(const LAS bf16x8*)(Am + trw * 72 + kk * 32 + fq * 8);
#pragma unroll
                for (int n = 0; n < 8; ++n) { const bf16x8 vf = *(const LAS bf16x8*)(vT + (n * 16 + fr) * 136 + c * 64 + kk * 32 + fq * 8); o[n] = MFMA_BF16(vf, pa, o[n]); }
            }
            GAS bf16_t* op = (GAS bf16_t*)ointra + (T0 + trw) * 512 + h * 128 + 4 * fq;
#pragma unroll
            for (int n = 0; n < 8; ++n) { u32x2 w; w.x = pk_f16(o[n][0], o[n][1]); w.y = pk_f16(o[n][2], o[n][3]); *(GAS u32x2*)(op + 16 * n) = w; }
        }
        {
            f32x4 kv[2][4];
#pragma unroll
            for (int mt = 0; mt < 2; ++mt)
#pragma unroll
                for (int n = 0; n < 4; ++n) kv[mt][n] = (f32x4){0.f, 0.f, 0.f, 0.f};
#pragma unroll
            for (int kk = 0; kk < 2; ++kk)
#pragma unroll
                for (int mt = 0; mt < 2; ++mt) {
                    const bf16x8 va = *(const LAS bf16x8*)(vT + ((wid & 3) * 32 + mt * 16 + fr) * 136 + c * 64 + kk * 32 + fq * 8);
#pragma unroll
                    for (int n = 0; n < 4; ++n) { const bf16x8 kf = *(const LAS bf16x8*)(kdT + (c * 64 + n * 16 + fr) * 72 + kk * 32 + fq * 8); kv[mt][n] = MFMA_BF16(kf, va, kv[mt][n]); }
                }
            GAS bf16_t* kp = (GAS bf16_t*)kvt + ((size_t)bh * 32 + cp * 2 + c) * 8192;
#pragma unroll
            for (int mt = 0; mt < 2; ++mt)
#pragma unroll
                for (int n = 0; n < 4; ++n) { u32x2 w; w.x = pk_f16(kv[mt][n][0], kv[mt][n][1]); w.y = pk_f16(kv[mt][n][2], kv[mt][n][3]); *(GAS u32x2*)(kp + ((wid & 3) * 32 + mt * 16 + fr) * 64 + n * 16 + 4 * fq) = w; }
        }
    }
}
__device__ void gla_scan(const Params& p, const int bid, const int nblk) {
    const GAS float* kvt = (const GAS float*)(p.ws + WS_KVT); const GAS float* decay = (const GAS float*)(p.ws + WS_DECAY); GAS bf16_t* sprev = (GAS bf16_t*)(p.ws + WS_SPREV);
    int tid_ = threadIdx.x; asm volatile("" : "+v"(tid_));
    for (int g = bid * 512 + tid_; g < 16 * 8192; g += nblk * 512) {
        const int bh = g >> 13, e = g & 8191, d = e & 63;
        float dc[32], kv[32];
#pragma unroll
        for (int n = 0; n < 32; ++n) { const size_t ci = (size_t)bh * 32 + n; dc[n] = decay[ci * 64 + d]; kv[n] = (float)((const GAS _Float16*)kvt)[ci * 8192 + e]; }
        float s = 0.f;
#pragma unroll
        for (int n = 0; n < 32; ++n) {
            const size_t ci = (size_t)bh * 32 + n;
            sprev[ci * 8192 + e] = f2bf(s);
            s = dc[n] * s + kv[n];
        }
    }
}
__device__ void gla_p3(const Params& p, int l, LAS unsigned char* lds, const int bid, const int nblk) {
    int tid_ = threadIdx.x; asm volatile("" : "+v"(tid_));
    const int tid = tid_, wid = __builtin_amdgcn_readfirstlane(tid >> 6), lane = tid & 63, fr = lane & 15, fq = lane >> 4;
    LAS bf16_t* qd = (LAS bf16_t*)lds;
    LAS bf16_t* sp = qd + 128 * 72;
    const GAS bf16_t* qdg = (const GAS bf16_t*)(p.ws + WS_QDG); const GAS bf16_t* sprev = (const GAS bf16_t*)(p.ws + WS_SPREV); const GAS float* ointra = (const GAS float*)(p.ws + WS_OINTRA);
    for (int it = bid; it < 256; it += nblk) {
        const int bh = it >> 4, cp = it & 15, b = bh >> 2, h = bh & 3;
        const size_t T0 = (size_t)b * SEQ + cp * 128;
        __syncthreads();
        const int c = wid >> 2, trw = c * 64 + (wid & 3) * 16 + fr;
        u32x2 ow[8];
        const GAS bf16_t* op = (const GAS bf16_t*)ointra + (T0 + trw) * 512 + h * 128 + 4 * fq;
#pragma unroll
        for (int n = 0; n < 8; ++n) ow[n] = *(const GAS u32x2*)(op + 16 * n);
        load_tile<8, 128>(qd, 72, qdg + T0 * 256 + h * 64, 256, tid);
        load_tile<8, 256>(sp, 72, sprev + ((size_t)bh * 32 + cp * 2) * 8192, 64, tid);
        __syncthreads();
        f32x4 o[8];
#pragma unroll
        for (int n = 0; n < 8; ++n) o[n] = (f32x4){hflo(ow[n].x), hfhi(ow[n].x), hflo(ow[n].y), hfhi(ow[n].y)};
#pragma unroll
        for (int kk = 0; kk < 2; ++kk) {
            const bf16x8 qa = *(const LAS bf16x8*)(qd + trw * 72 + kk * 32 + fq * 8);
#pragma unroll
            for (int n = 0; n < 8; ++n) { const bf16x8 sf = *(const LAS bf16x8*)(sp + (c * 128 + n * 16 + fr) * 72 + kk * 32 + fq * 8); o[n] = MFMA_BF16(sf, qa, o[n]); }
        }
        finish_head(p, l, o, T0 + trw, 1024 + h * 128, fq);
    }
}

__device__ void sgu_phase(const Params& p, int l, LAS unsigned char* lds, const int bid, const int nblk) {
    int tid_ = threadIdx.x; asm volatile("" : "+v"(tid_));
    const int tid = tid_, wid = __builtin_amdgcn_readfirstlane(tid >> 6), lane = tid & 63, fr = lane & 15, fq = lane >> 4;
    LAS bf16_t* Wt = (LAS bf16_t*)lds;
    LAS bf16_t* Vt = Wt + 128 * 136;
    LAS float* rstd = (LAS float*)(Vt + 128 * 136);
    const GAS bf16_t* vT = (const GAS bf16_t*)(p.ws + WS_SGUVT); const GAS bf16_t* vr = (const GAS bf16_t*)(p.ws + WS_SGUV); const GAS bf16_t* uu = (const GAS bf16_t*)(p.ws + WS_SGUU);
    for (int it = bid; it < 256; it += nblk) {
        const int g = it & 3, bn = it >> 2, b = bn >> 4, n_ = bn & 15;
        const size_t T0 = (size_t)b * SEQ + n_ * 128;
        __syncthreads();
        {
            u32x4 rv[16];
#pragma unroll
            for (int i = 0; i < 16; ++i) rv[i] = *(const u32x4*)(vr + (T0 + wid * 16 + i) * 512 + lane * 8);
#pragma unroll
            for (int i = 0; i < 16; ++i) {
                float a = 0.f;
#pragma unroll
                for (int e = 0; e < 4; ++e) { const float x0 = bflo(rv[i][e]), x1 = bfhi(rv[i][e]); a += x0 * x0 + x1 * x1; }
                a = wave_sum(a);
                if (lane == 0) rstd[wid * 16 + i] = 1.0f / sqrtf(a * (1.0f / 512.0f) + EPS);
            }
        }
        load_tile<16, 128>(Vt, 136, vT + ((size_t)b * 512 + g * 128) * SEQ + n_ * 128, SEQ, tid);
        __syncthreads();
        {
            const f32x4* wsg = (const f32x4*)(p.w_sgu + ((size_t)l * 4 + g) * 16384);
#pragma unroll
            for (int i = 0; i < 8; ++i) {
                const int e4 = tid + 512 * i, t = e4 >> 5, s0 = (e4 & 31) * 4;
                const f32x4 w = wsg[e4]; const f32x4 r4 = *(const LAS f32x4*)(rstd + s0);
                u32x2 o2; o2.x = pk_bf16(s0 <= t ? w[0] * r4[0] : 0.f, s0 + 1 <= t ? w[1] * r4[1] : 0.f); o2.y = pk_bf16(s0 + 2 <= t ? w[2] * r4[2] : 0.f, s0 + 3 <= t ? w[3] * r4[3] : 0.f);
                *(LAS u32x2*)(Wt + t * 136 + s0) = o2;
            }
        }
        __syncthreads();
        f32x4 o[8];
#pragma unroll
        for (int n = 0; n < 8; ++n) o[n] = (f32x4){0.f, 0.f, 0.f, 0.f};
        const int t = wid * 16 + fr;
#pragma unroll
        for (int kk = 0; kk < 4; ++kk) {
            const bf16x8 wa = *(const LAS bf16x8*)(Wt + t * 136 + kk * 32 + fq * 8);
#pragma unroll
            for (int n = 0; n < 8; ++n) { const bf16x8 vf = *(const LAS bf16x8*)(Vt + (n * 16 + fr) * 136 + kk * 32 + fq * 8); o[n] = MFMA_BF16(vf, wa, o[n]); }
        }
        const float bs = p.b_sgu[((size_t)l * 4 + g) * 128 + t];
        const float* gn = p.sgu_norm + (size_t)l * 512 + g * 128 + 4 * fq;
        const GAS bf16_t* up = uu + (T0 + t) * 512 + g * 128 + 4 * fq;
#pragma unroll
        for (int n = 0; n < 8; ++n) {
            const f32x4 gg = *(const f32x4*)(gn + 16 * n); const u32x2 u2 = *(const u32x2*)(up + 16 * n);
            o[n][0] = bflo(u2.x) * (o[n][0] * gg[0] + bs); o[n][1] = bfhi(u2.x) * (o[n][1] * gg[1] + bs);
            o[n][2] = bflo(u2.y) * (o[n][2] * gg[2] + bs); o[n][3] = bfhi(u2.y) * (o[n][3] * gg[3] + bs);
        }
        finish_head(p, l, o, T0 + t, 1536 + g * 128, fq);
    }
}

#define XA_BAR() do { asm volatile("s_waitcnt lgkmcnt(0)" ::: "memory"); __builtin_amdgcn_s_barrier(); asm volatile("" ::: "memory"); } while (0)
__device__ void xattn_phase(const Params& p, int l, LAS unsigned char* lds, const int bid, const int nblk) {
    int tid_ = threadIdx.x; asm volatile("" : "+v"(tid_));
    const int tid = tid_, wid = __builtin_amdgcn_readfirstlane(tid >> 6), lane = tid & 63, fr = lane & 15, fq = lane >> 4;
    LAS bf16_t* KV = (LAS bf16_t*)lds;
    LAS bf16_t* Ps = KV + 256 * 136 + wid * 16 * 264;
    LAS bf16_t* St = KV;
    LAS float* rs = (LAS float*)(lds + 4 * 128 * 136 * 2);
    const GAS bf16_t* xb = (const GAS bf16_t*)(p.ws + WS_X);
    const GAS bf16_t* wq = (const GAS bf16_t*)(p.ws + WS_WXQ) + (size_t)l * 512 * DM;
    const GAS bf16_t* kx = (const GAS bf16_t*)(p.ws + WS_KX) + (size_t)l * MEMTOK * 512;
    const GAS bf16_t* vx = (const GAS bf16_t*)(p.ws + WS_VXT) + (size_t)l * MEMTOK * 512; GAS bf16_t* xo = (GAS bf16_t*)(p.ws + WS_XO);
    const int br = tid >> 4, bc = (tid & 15) * 8;
    for (int it = bid; it < 256; it += nblk) {
        const int qt = it & 15, bh = it >> 4, b = bh >> 2, h = bh & 3;
        const size_t T0 = (size_t)b * SEQ + qt * 128;
        const GAS bf16_t* xa = xb + (T0 + br) * DM + bc; const GAS bf16_t* wb = wq + ((size_t)h * 128 + br) * DM + bc;
        u32x4 sa[3][4], sb[3][4]; float ssq[4] = {0.f, 0.f, 0.f, 0.f};
#define XA_LOAD(set, ks) do { _Pragma("unroll") for (int j = 0; j < 4; ++j) { sa[set][j] = *(const u32x4*)(xa + (size_t)(32 * j) * DM + (ks) * 128); sb[set][j] = *(const u32x4*)(wb + (size_t)(32 * j) * DM + (ks) * 128); } } while (0)
#define XA_WRITE(set, buf) do { LAS bf16_t* A_ = St + (buf) * (2 * 128 * 136); _Pragma("unroll") for (int j = 0; j < 4; ++j) { const u32x4 x_ = sa[set][j]; \
            _Pragma("unroll") for (int e = 0; e < 4; ++e) { const float lo_ = hflo(x_[e]), hi_ = hfhi(x_[e]); ssq[j] += lo_ * lo_ + hi_ * hi_; } \
            *(LAS u32x4*)(A_ + (br + 32 * j) * 136 + bc) = x_; *(LAS u32x4*)(A_ + 128 * 136 + (br + 32 * j) * 136 + bc) = sb[set][j]; } } while (0)
        __syncthreads();
        XA_LOAD(0, 0); XA_LOAD(1, 1); XA_LOAD(2, 2);
        __builtin_amdgcn_sched_barrier(0);
        XA_WRITE(0, 0); __builtin_amdgcn_sched_barrier(0); XA_LOAD(0, 3);
        __builtin_amdgcn_sched_barrier(0);
        f32x4 acc[8];
#pragma unroll
        for (int n = 0; n < 8; ++n) acc[n] = (f32x4){0.f, 0.f, 0.f, 0.f};
        for (int k3 = 0; k3 < 18; k3 += 3) {
#pragma unroll
          for (int i = 0; i < 3; ++i) {
            const int ks = k3 + i;
            if (ks < 16) {
              XA_BAR();
              __builtin_amdgcn_s_setprio(1);
              { const LAS bf16_t* A_ = St + (ks & 1) * (2 * 128 * 136); const LAS bf16_t* B_ = A_ + 128 * 136;
#pragma unroll
                for (int kk = 0; kk < 4; ++kk) {
                  const f16x8 af = *(const LAS f16x8*)(A_ + (wid * 16 + fr) * 136 + kk * 32 + fq * 8);
#pragma unroll
                  for (int n = 0; n < 8; ++n) { const f16x8 bf = *(const LAS f16x8*)(B_ + (n * 16 + fr) * 136 + kk * 32 + fq * 8); acc[n] = MFMA_F16(bf, af, acc[n]); }
                  __builtin_amdgcn_sched_barrier(0);
                } }
              __builtin_amdgcn_s_setprio(0);
              if (ks + 1 < 16) { XA_WRITE((i + 1) % 3, (ks + 1) & 1); __builtin_amdgcn_sched_barrier(0); if (ks + 4 < 16) XA_LOAD((i + 1) % 3, ks + 4); }
              __builtin_amdgcn_sched_barrier(0);
            }
          }
        }
#pragma unroll
        for (int j = 0; j < 4; ++j) {
            float a = ssq[j];
            a += __shfl_xor(a, 1); a += __shfl_xor(a, 2); a += __shfl_xor(a, 4); a += __shfl_xor(a, 8);
            if ((tid & 15) == 0) rs[br + 32 * j] = 1.0f / sqrtf(a * (1.0f / DM) + EPS);
        }
        __syncthreads();
        {
            const float sc = rs[wid * 16 + fr] * 0.08838834764831845f;
#pragma unroll
            for (int n = 0; n < 8; ++n) { u32x2 w; w.x = pk_bf16(acc[n][0] * sc, acc[n][1] * sc); w.y = pk_bf16(acc[n][2] * sc, acc[n][3] * sc); *(LAS u32x2*)(St + (wid * 16 + fr) * 136 + n * 16 + 4 * fq) = w; }
        }
        LDS_FENCE();
        bf16x8 aq[4];
#pragma unroll
        for (int kk = 0; kk < 4; ++kk) aq[kk] = *(const LAS bf16x8*)(St + (wid * 16 + fr) * 136 + kk * 32 + fq * 8);
        __syncthreads();
        { int tk = tid; asm volatile("" : "+v"(tk));
          load_tile<16, 256>(KV, 136, kx + ((size_t)b * 256) * 512 + h * 128, 512, tk); }
        __syncthreads();
        __builtin_amdgcn_s_setprio(1);
        f32x4 sc[16];
#pragma unroll
        for (int n = 0; n < 16; ++n) sc[n] = (f32x4){0.f, 0.f, 0.f, 0.f};
#pragma unroll
        for (int kk = 0; kk < 4; ++kk)
#pragma unroll
            for (int n = 0; n < 16; ++n) { const bf16x8 kf = *(const LAS bf16x8*)(KV + (n * 16 + fr) * 136 + kk * 32 + fq * 8); sc[n] = MFMA_BF16(kf, aq[kk], sc[n]); }
        __builtin_amdgcn_s_setprio(0);
        float mx = -3.0e38f;
#pragma unroll
        for (int n = 0; n < 16; ++n) mx = fmaxf(mx, fmaxf(fmaxf(sc[n][0], sc[n][1]), fmaxf(sc[n][2], sc[n][3])));
        mx = fmaxf(mx, __shfl_xor(mx, 16)); mx = fmaxf(mx, __shfl_xor(mx, 32));
        float sm = 0.f;
#pragma unroll
        for (int n = 0; n < 16; ++n) {
#pragma unroll
            for (int r = 0; r < 4; ++r) { sc[n][r] = __expf(sc[n][r] - mx); sm += sc[n][r]; }
        }
        sm += __shfl_xor(sm, 16); sm += __shfl_xor(sm, 32);
        const float inv = 1.0f / sm;
#pragma unroll
        for (int n = 0; n < 16; ++n) {
            u32x2 w; w.x = pk_bf16(sc[n][0] * inv, sc[n][1] * inv); w.y = pk_bf16(sc[n][2] * inv, sc[n][3] * inv);
            *(LAS u32x2*)(Ps + fr * 264 + n * 16 + 4 * fq) = w;
        }
        __syncthreads();
        { int tk = tid; asm volatile("" : "+v"(tk));
          load_tile<32, 128>(KV, 264, vx + ((size_t)(b * 4 + h) * 128) * 256, 256, tk); }
        __syncthreads();
        __builtin_amdgcn_s_setprio(1);
        f32x4 o[8];
#pragma unroll
        for (int n = 0; n < 8; ++n) o[n] = (f32x4){0.f, 0.f, 0.f, 0.f};
#pragma unroll
        for (int kk = 0; kk < 8; ++kk) {
            const bf16x8 pf = *(const LAS bf16x8*)(Ps + fr * 264 + kk * 32 + fq * 8);
#pragma unroll
            for (int n = 0; n < 8; ++n) { const bf16x8 vf = *(const LAS bf16x8*)(KV + (n * 16 + fr) * 264 + kk * 32 + fq * 8); o[n] = MFMA_BF16(vf, pf, o[n]); }
        }
        __builtin_amdgcn_s_setprio(0);
        GAS bf16_t* op = xo + (T0 + wid * 16 + fr) * 512 + h * 128 + 4 * fq;
#pragma unroll
        for (int n = 0; n < 8; ++n) { u32x2 w; w.x = pk_bf16(o[n][0], o[n][1]); w.y = pk_bf16(o[n][2], o[n][3]); *(u32x2*)(op + 16 * n) = w; }
#undef XA_LOAD
#undef XA_WRITE
    }
}

#define XB_TMO      128
#define XB_XCNT(j)  (256  + 64 * (j))
#define XB_XSUB(j)  (1280 + 64 * (j))
#define XB_XGEN(j)  (2304 + 64 * (j))
#define XB_TOP      3328
#define XB_TOPGEN   3392
#define XCD_BAR_WORDS 3456
#define XB_SPIN_CAP (1u << 18)
__device__ __forceinline__ unsigned xb_ld(unsigned* p)              { return __hip_atomic_load(p, __ATOMIC_RELAXED, __HIP_MEMORY_SCOPE_AGENT); }
__device__ __forceinline__ unsigned xb_add(unsigned* p, unsigned v) { return __hip_atomic_fetch_add(p, v, __ATOMIC_RELAXED, __HIP_MEMORY_SCOPE_AGENT); }
__device__ __forceinline__ unsigned xb_xcc_id() { return (unsigned)__builtin_amdgcn_s_getreg((3 << 11) | 20) & 0xFu; }
#define XB_SPIN(cond, bar) do { unsigned _sp = 0; while (cond) { __builtin_amdgcn_s_sleep(1); \
    if ((++_sp & 255u) == 0u) { if (xb_ld(&(bar)[XB_TMO])) break; if (_sp > XB_SPIN_CAP) { atomicAdd(&(bar)[XB_TMO], 1u); break; } } } } while (0)
struct XcdBarrier { unsigned* bar; unsigned x; volatile LAS unsigned* st; };
__device__ __forceinline__ XcdBarrier xcd_barrier_post(unsigned* bar, volatile LAS unsigned* st) {
    XcdBarrier b; b.bar = bar; b.x = xb_xcc_id(); b.st = st;
    if (threadIdx.x == 0) (void)xb_add(&bar[XB_XCNT(b.x)], 1u);
    return b;
}
__device__ __forceinline__ void xcd_barrier_complete(unsigned* bar, unsigned x, unsigned& nloc, unsigned& nx) {
    const unsigned G = gridDim.x * gridDim.y * gridDim.z;
    unsigned sum, cnt, mine, sp = 0u;
    for (;;) {
        sum = 0u; cnt = 0u; mine = 0u;
#pragma unroll 1
        for (unsigned j = 0; j < 16; ++j) { const unsigned c = xb_ld(&bar[XB_XCNT(j)]); sum += c; cnt += (c > 0u) ? 1u : 0u; mine = (j == x) ? c : mine; }
        if (sum == G) break;
        __builtin_amdgcn_s_sleep(1);
        if ((++sp & 255u) == 0u) { if (xb_ld(&bar[XB_TMO])) break; if (sp > XB_SPIN_CAP) { atomicAdd(&bar[XB_TMO], 1u); break; } }
    }
    nloc = mine > 0u ? mine : 1u; nx = cnt > 0u ? cnt : 1u;
}
__device__ __forceinline__ void xcd_barrier(const XcdBarrier& b) {
    asm volatile("s_waitcnt vmcnt(0)" ::: "memory");
    __syncthreads();
    if (threadIdx.x == 0) {
        unsigned* bar = b.bar; unsigned bx_ = b.x; asm volatile("" : "+s"(bar), "+s"(bx_));
        __builtin_amdgcn_s_waitcnt(0);
        unsigned nloc = b.st[0], nx = b.st[1];
        if (nloc == 0u) { xcd_barrier_complete(bar, bx_, nloc, nx); b.st[0] = nloc; b.st[1] = nx; }
        const unsigned old = xb_add(&bar[XB_XSUB(bx_)], 1u);
        const unsigned gen = old / nloc;
        if (old + 1u == (gen + 1u) * nloc) {
            __builtin_amdgcn_fence(__ATOMIC_RELEASE, "agent");
            asm volatile("s_waitcnt vmcnt(0)" ::: "memory");
            const unsigned og = xb_add(&bar[XB_TOP], 1u);
            const unsigned tg = og / nx;
            if (og + 1u == (tg + 1u) * nx) xb_add(&bar[XB_TOPGEN], 1u);
            else XB_SPIN(xb_ld(&bar[XB_TOPGEN]) == tg, bar);
            __builtin_amdgcn_fence(__ATOMIC_ACQUIRE, "agent");
            xb_add(&bar[XB_XGEN(bx_)], 1u);
            asm volatile("s_waitcnt vmcnt(0)" ::: "memory");
        } else {
            XB_SPIN(xb_ld(&bar[XB_XGEN(bx_)]) == gen, bar);
            __builtin_amdgcn_fence(__ATOMIC_ACQUIRE, "agent");
            asm volatile("s_waitcnt vmcnt(0)" ::: "memory");
        }
    }
    __syncthreads();
}

constexpr int PPL = 8;
constexpr int N_PHASES = 1 + DEPTH * PPL;
__device__ __forceinline__ void phase_run(const Params& p0, int ph, LAS unsigned char* lds0) {
    int tid_ = threadIdx.x; asm volatile("" : "+v"(tid_));
    const int tid = tid_, lane = tid & 63, wid = tid >> 6;
    int G_ = gridDim.x, c_ = blockIdx.x; asm volatile("" : "+s"(G_), "+s"(c_));
    const int G = G_, c = c_;
    const int gw = c * 8 + wid, nw = G * 8;
    LAS unsigned char* lds = lds0; asm volatile("" : "+s"(lds));
#if defined(__HIP_DEVICE_COMPILE__)
    const __attribute__((address_space(4))) Params* kp = (const __attribute__((address_space(4))) Params*)__builtin_amdgcn_kernarg_segment_ptr(); asm volatile("" : "+s"(kp));
#define LOADP() Params p = *kp; { unsigned char* w_ = p.ws; asm volatile("" : "+s"(w_)); p.ws = w_; } unsigned char* ws = p.ws; (void)ws
#else
#define LOADP() Params p = p0; unsigned char* ws = p.ws; (void)ws
#endif
    __syncthreads();
#ifdef ONLY
    if (ph != 0 && ((ph - 1) % PPL) != ONLY) return;
    if (ph == 0 && ONLY != 10) return;
#endif
    if (ph == 0) { LOADP(); prologue(p, lds, c, G); return; }
    const int l = (ph - 1) / PPL, s = (ph - 1) % PPL;
    if (s == 0 || s == 4 || s == 6) {
        LOADP();
        SchedAny S{ws, (l == 0) ? p.x : (const float*)(const void*)(ws + WS_X), l, G, c, s == 0 ? 0 : (s == 4 ? 1 : 3)};
        pg8::gemm_phase(lds, s == 6 ? 512 : DM, S);
        return;
    }
    switch (s) {
    case 1: { LOADP(); gla_p1(p, l, lds, c, G); sgu_phase(p, l, lds, c, G); } break;
    case 2: { LOADP(); gla_scan(p, c, G); sb_phase(p, l, lds, c, G); } break;
    case 3: { LOADP(); gla_p3(p, l, lds, c, G); } break;
    case 5: { LOADP(); xattn_phase(p, l, lds, c, G); } break;
    default: { LOADP();
        if (l < DEPTH - 1) norm_rows<false, true>((const GAS void*)(ws + WS_X), p.norm_mix + (l + 1) * DM, (GAS bf16_t*)(ws + WS_H), NTOK, gw, nw, lane);
        else norm_rows<true, true>((const GAS void*)(ws + WS_X), p.final_norm, (GAS void*)p.out, NTOK, gw, nw, lane); }
        break;
    }
#undef LOADP
}

__global__ void __launch_bounds__(512, 2) fwd_kernel(Params p) {
    extern __shared__ __attribute__((aligned(16))) unsigned char lds_raw[];
    LAS unsigned char* lds = (LAS unsigned char*)lds_raw;
#if MEGA
    if (p.ph_hi < 0) cg::this_grid().sync();
    volatile LAS unsigned* st = (volatile LAS unsigned*)(lds + LDS_BYTES - 16);
    if (threadIdx.x == 0) { st[0] = 0u; st[1] = 0u; st[2] = 0u; st[3] = 0u; }
    __syncthreads();
    const XcdBarrier bar = xcd_barrier_post((unsigned*)(p.ws + WS_BAR), st);
    for (int ph = p.ph_lo; ph < p.ph_hi; ++ph) {
        phase_run(p, ph, lds);
#ifdef PROBE_DUP
        if ((PROBE_DUP == 10 && ph == 0) || (ph > 0 && (ph - 1) % PPL == PROBE_DUP)) { xcd_barrier(bar); phase_run(p, ph, lds); }
#endif
        if (ph + 1 < p.ph_hi) xcd_barrier(bar);
    }
#else
    for (int ph = p.ph_lo; ph < p.ph_hi; ++ph) phase_run(p, ph, lds);
#endif
}

extern "C" void kernel_launch(void* const* d_in, const int* in_sizes, int n_in, void* d_out, int out_size, void* d_ws, size_t ws_size, hipStream_t stream) {
    static int grid = 0;
    if (grid == 0) {
        if (n_in != 17 || ws_size < WS_END) { fprintf(stderr, "kernel_launch: unexpected problem (n_in %d, ws %zu < %zu)\n", n_in, ws_size, (size_t)WS_END); grid = -1; return; }
        int dev = 0, cus = 0, per_cu = 0;
        hipGetDevice(&dev); hipDeviceGetAttribute(&cus, hipDeviceAttributeMultiprocessorCount, dev);
        if (hipFuncSetAttribute((const void*)fwd_kernel, hipFuncAttributeMaxDynamicSharedMemorySize, LDS_BYTES) != hipSuccess) { fprintf(stderr, "kernel_launch: hipFuncSetAttribute failed\n"); grid = -1; return; }
        if (hipOccupancyMaxActiveBlocksPerMultiprocessor(&per_cu, (const void*)fwd_kernel, 512, LDS_BYTES) != hipSuccess || per_cu < 1) { fprintf(stderr, "kernel_launch: occupancy query gave %d\n", per_cu); per_cu = 1; }
        (void)hipGetLastError();
        grid = cus * 1;
        if (grid <= 0) grid = 256;
    }
    if (grid < 0) return;
    Params p{};
    p.x = (const float*)d_in[0]; p.mem = (const float*)d_in[1]; p.norm_mix = (const float*)d_in[2]; p.w_in = (const float*)d_in[3];
    p.w_up = (const float*)d_in[4]; p.b_gate = (const float*)d_in[5]; p.sgu_norm = (const float*)d_in[6]; p.w_sgu = (const float*)d_in[7];
    p.b_sgu = (const float*)d_in[8]; p.out_norm = (const float*)d_in[9]; p.w_out = (const float*)d_in[10]; p.norm_xattn = (const float*)d_in[11];
    p.norm_mem = (const float*)d_in[12]; p.w_xq = (const float*)d_in[13]; p.w_xkv = (const float*)d_in[14]; p.w_xo = (const float*)d_in[15];
    p.final_norm = (const float*)d_in[16];
    p.out = (float*)d_out; p.ws = (unsigned char*)d_ws;
#if MEGA
    p.ph_lo = 0; p.ph_hi = N_PHASES;
    if (hipMemsetAsync((char*)d_ws + WS_BAR, 0, 16384, stream) != hipSuccess) { fprintf(stderr, "kernel_launch: memset of the barrier words failed\n"); return; }
    void* args[] = {&p};
    hipError_t e = hipLaunchCooperativeKernel((const void*)fwd_kernel, dim3(grid), dim3(512), args, LDS_BYTES, stream);
    if (e != hipSuccess) fprintf(stderr, "cooperative launch failed: %s (grid %d)\n", hipGetErrorString(e), grid);
#else
    for (int ph = 0; ph < N_PHASES; ++ph) {
        p.ph_lo = ph; p.ph_hi = ph + 1;
        hipLaunchKernelGGL(fwd_kernel, dim3(grid), dim3(512), LDS_BYTES, stream, p);
    }
#endif
}
```

```cpp
#include <hip/hip_runtime.h>
#include <hip/hip_cooperative_groups.h>
#include <cstdio>
#include <cstdint>
namespace cg = cooperative_groups;

#ifndef MEGA
#define MEGA 1
#endif

#define LAS __attribute__((address_space(3)))
#define GAS __attribute__((address_space(1)))
typedef unsigned short bf16_t;
typedef short bf16x8 __attribute__((ext_vector_type(8)));
typedef _Float16 f16x8 __attribute__((ext_vector_type(8)));
typedef _Float16 f16x4 __attribute__((ext_vector_type(4)));
typedef float f32x4 __attribute__((ext_vector_type(4)));
typedef float f32x2_t __attribute__((ext_vector_type(2)));
typedef __bf16 bf16x2_t __attribute__((ext_vector_type(2)));
typedef unsigned u32x2 __attribute__((ext_vector_type(2)));
typedef unsigned u32x4 __attribute__((ext_vector_type(4)));

constexpr int DM = 2048, NB = 4, SEQ = 2048, DEPTH = 4, NTOK = NB * SEQ;
constexpr int INW = 7184;
constexpr int NWT = 7424;
constexpr int NMEM = 256, MEMTOK = NB * NMEM;
constexpr float EPS = 1e-6f;
constexpr int LDS_BYTES = 147456;

constexpr size_t al256(size_t x) { return (x + 255) & ~(size_t)255; }
constexpr size_t WS_WIN = 0;
constexpr size_t WS_WOUT = WS_WIN + (size_t)DEPTH * NWT * DM * 2;
constexpr size_t WS_WXQ = WS_WOUT + (size_t)DEPTH * DM * DM * 2;
constexpr size_t WS_WXKV = WS_WXQ + (size_t)DEPTH * 512 * DM * 2;
constexpr size_t WS_WXO = WS_WXKV + (size_t)DEPTH * 1024 * DM * 2;
constexpr size_t WS_MEMN = WS_WXO + (size_t)DEPTH * DM * 512 * 2;
constexpr size_t WS_KX = WS_MEMN + (size_t)DEPTH * MEMTOK * DM * 2;
constexpr size_t WS_VXT = WS_KX + (size_t)DEPTH * MEMTOK * 512 * 2;
constexpr size_t WS_X = WS_VXT + (size_t)DEPTH * MEMTOK * 512 * 2;
constexpr size_t WS_H = WS_X + (size_t)NTOK * DM * 4;
constexpr size_t WS_Q = WS_H + (size_t)NTOK * DM * 2;
constexpr size_t WS_K = WS_Q + (size_t)NTOK * 1024 * 2;
constexpr size_t WS_SBVT = WS_K + (size_t)NTOK * 1024 * 2;
constexpr size_t WS_GATE = WS_SBVT + (size_t)NTOK * 1024 * 2;
constexpr size_t WS_GLAQ = WS_GATE + (size_t)NTOK * 2048 * 2;
constexpr size_t WS_GLAK = WS_GLAQ + (size_t)NTOK * 256 * 2;
constexpr size_t WS_GLAVT = WS_GLAK + (size_t)NTOK * 256 * 2;
constexpr size_t WS_SGUU = WS_GLAVT + (size_t)NTOK * 512 * 2;
constexpr size_t WS_SGUVT = WS_SGUU + (size_t)NTOK * 512 * 2;
constexpr size_t WS_GLAR = WS_SGUVT + (size_t)NTOK * 512 * 2;
constexpr size_t WS_MIX = WS_GLAR + (size_t)NTOK * 16 * 4;
constexpr size_t WS_OINTRA = WS_MIX + (size_t)NTOK * 2048 * 2;
constexpr size_t WS_QDG = WS_OINTRA + (size_t)NTOK * 512 * 4;
constexpr size_t WS_KVT = WS_QDG + (size_t)NTOK * 256 * 2;
constexpr size_t WS_DECAY = WS_KVT + (size_t)512 * 8192 * 4;
constexpr size_t WS_SPREV = WS_DECAY + (size_t)512 * 64 * 4;
constexpr size_t WS_XQ = WS_SPREV + (size_t)512 * 8192 * 2;
constexpr size_t WS_XO = WS_XQ + (size_t)NTOK * 512 * 2;
constexpr size_t WS_SGUV = WS_XO + (size_t)NTOK * 512 * 2;
constexpr size_t WS_BAR = WS_SGUV + (size_t)NTOK * 512 * 2;
constexpr size_t WS_END = WS_BAR + 16384;

struct Params {
    const float* x; const float* mem; const float* norm_mix; const float* w_in; const float* w_up; const float* b_gate;
    const float* sgu_norm; const float* w_sgu; const float* b_sgu; const float* out_norm; const float* w_out;
    const float* norm_xattn; const float* norm_mem; const float* w_xq; const float* w_xkv; const float* w_xo; const float* final_norm;
    float* out; unsigned char* ws;
    int ph_lo, ph_hi;
};

__device__ __forceinline__ unsigned pk_bf16(float lo, float hi) { f32x2_t v = {lo, hi}; bf16x2_t b = __builtin_convertvector(v, bf16x2_t); return __builtin_bit_cast(unsigned, b); }
__device__ __forceinline__ bf16_t f2bf(float f) { unsigned u = __builtin_bit_cast(unsigned, f); return (bf16_t)((u + 0x7fffu + ((u >> 16) & 1u)) >> 16); }
__device__ __forceinline__ float bf2f(unsigned h) { return __builtin_bit_cast(float, h << 16); }
__device__ __forceinline__ float bflo(unsigned w) { return __builtin_bit_cast(float, w << 16); }
__device__ __forceinline__ float bfhi(unsigned w) { return __builtin_bit_cast(float, w & 0xffff0000u); }
typedef _Float16 f16x2_t __attribute__((ext_vector_type(2)));
__device__ __forceinline__ unsigned pk_f16(float lo, float hi) { f16x2_t h = {(_Float16)lo, (_Float16)hi}; return __builtin_bit_cast(unsigned, h); }
__device__ __forceinline__ float hflo(unsigned w) { return (float)__builtin_bit_cast(f16x2_t, w)[0]; }
__device__ __forceinline__ float hfhi(unsigned w) { return (float)__builtin_bit_cast(f16x2_t, w)[1]; }
__device__ __forceinline__ float wave_sum(float v) {
#pragma unroll
    for (int o = 1; o < 64; o <<= 1) v += __shfl_xor(v, o);
    return v;
}
__device__ __forceinline__ float silu_f(float x) { return x * __builtin_amdgcn_rcpf(1.0f + __expf(-x)); }
__device__ __forceinline__ float gelu_f(float x) {
    const float u = 0.7978845608028654f * (x + 0.044715f * x * x * x);
    return x * __builtin_amdgcn_rcpf(1.0f + __expf(-2.0f * u));
}
__device__ __forceinline__ float softplus_f(float z) { return fmaxf(z, 0.0f) + __logf(1.0f + __expf(-fabsf(z))); }
#define LDS_FENCE() asm volatile("s_waitcnt lgkmcnt(0)" ::: "memory")

template <int C8, int ROWS>
__device__ __forceinline__ void load_tile(LAS bf16_t* dst, int ldd, const GAS bf16_t* src, size_t lds_, int tid) {
    constexpr int NP = ROWS * C8 / 512;
    static_assert(ROWS * C8 % 512 == 0, "load_tile: whole pieces per thread");
    u32x4 v[NP];
#pragma unroll
    for (int i = 0; i < NP; ++i) { const int c = tid + 512 * i, r = c / C8, cc = c - r * C8; v[i] = *(const GAS u32x4*)(src + (size_t)r * lds_ + cc * 8); }
#pragma unroll
    for (int i = 0; i < NP; ++i) { const int c = tid + 512 * i, r = c / C8, cc = c - r * C8; *(LAS u32x4*)(dst + r * ldd + cc * 8) = v[i]; }
}
#define MFMA_BF16(a, b, c) __builtin_amdgcn_mfma_f32_16x16x32_bf16((a), (b), (c), 0, 0, 0)
#define MFMA_F16(a, b, c) __builtin_amdgcn_mfma_f32_16x16x32_f16((a), (b), (c), 0, 0, 0)

namespace pg8 {
constexpr int BM = 256, BK = 64, HALF = 128, HTB = HALF * BK * 2, STAGE_BYTES = 8 * HTB;
__device__ __forceinline__ int lds_byte(int r, int c) { const int st = (r >> 4) * 2 + (c >> 5), rr = r & 15, cc = c & 31, ob = rr * 64 + cc * 2; return st * 1024 + (ob ^ (((ob >> 9) & 1) << 5)); }
__device__ __forceinline__ void stage_rc(int b, int& R, int& C) { const int st = b / 1024, sb = b % 1024, swz = sb ^ (((sb >> 9) & 1) << 5); R = (st >> 1) * 16 + swz / 64; C = (st & 1) * 32 + (swz % 64) / 2; }

__device__ __forceinline__ int perm32(int rho) { const int n = rho >> 4, i = rho & 15; return 8 * (i >> 2) + 4 * n + (i & 3); }
struct Unit { void* out; const float* res; int row0, col0, ld, mode, act; float scale; };

__device__ __forceinline__ void tile_map(int L, int nM, int nN, int& pm, int& pn) {
    const int nwg = nM * nN; int wgid = L;
    { const int q = nwg / 8, r = nwg % 8, xcd = wgid % 8, off = wgid / 8; wgid = (xcd < r ? xcd * (q + 1) : r * (q + 1) + (xcd - r) * q) + off; }
    const int nig = 8 * nN, gid = wgid / nig, fm = gid * 8, gsz = (nM - fm) < 8 ? (nM - fm) : 8;
    pm = fm + ((wgid % nig) % gsz); pn = (wgid % nig) / gsz;
}

struct EpiGen {
    __device__ __forceinline__ void operator()(const f32x4 (&acc)[2][2][4][2], const Unit& u, int wr, int wc, int fr, int fq) const {
        if (u.mode == 0) {
            GAS bf16_t* O = (GAS bf16_t*)u.out;
#pragma unroll
            for (int ai = 0; ai < 2; ++ai)
#pragma unroll
                for (int m = 0; m < 4; ++m) {
                    GAS bf16_t* rp = O + (size_t)(u.row0 + ai * 128 + wr * 64 + m * 16 + fr) * u.ld + u.col0 + wc * 32 + 8 * fq;
#pragma unroll
                    for (int bj = 0; bj < 2; ++bj) {
                        f32x4 v0 = acc[ai][bj][m][0] * u.scale, v1 = acc[ai][bj][m][1] * u.scale;
                        if (u.act == 1) { v0[0] = silu_f(v0[0]); v0[1] = silu_f(v0[1]); v0[2] = silu_f(v0[2]); v0[3] = silu_f(v0[3]); v1[0] = silu_f(v1[0]); v1[1] = silu_f(v1[1]); v1[2] = silu_f(v1[2]); v1[3] = silu_f(v1[3]); }
                        else if (u.act == 2) { v0[0] = gelu_f(v0[0]); v0[1] = gelu_f(v0[1]); v0[2] = gelu_f(v0[2]); v0[3] = gelu_f(v0[3]); v1[0] = gelu_f(v1[0]); v1[1] = gelu_f(v1[1]); v1[2] = gelu_f(v1[2]); v1[3] = gelu_f(v1[3]); }
                        u32x4 w; w.x = pk_bf16(v0[0], v0[1]); w.y = pk_bf16(v0[2], v0[3]); w.z = pk_bf16(v1[0], v1[1]); w.w = pk_bf16(v1[2], v1[3]);
                        *(GAS u32x4*)(rp + bj * 128) = w;
                    }
                }
        } else if (u.mode == 1) {
            GAS bf16_t* O = (GAS bf16_t*)u.out;
#pragma unroll
            for (int ai = 0; ai < 2; ++ai)
#pragma unroll
                for (int m = 0; m < 4; ++m) {
                    const size_t off = (size_t)(u.row0 + ai * 128 + wr * 64 + m * 16 + fr) * u.ld + u.col0 + wc * 32 + 8 * fq;
#pragma unroll
                    for (int bj = 0; bj < 2; ++bj) {
                        const f32x4 v0 = acc[ai][bj][m][0], v1 = acc[ai][bj][m][1];
                        u32x4 w; w.x = pk_f16(v0[0], v0[1]); w.y = pk_f16(v0[2], v0[3]); w.z = pk_f16(v1[0], v1[1]); w.w = pk_f16(v1[2], v1[3]);
                        *(GAS u32x4*)(O + off + bj * 128) = w;
                    }
                }
        } else {
            float* O = (float*)u.out;
            if (wc == 0 && fq < 2) {
#pragma unroll
                for (int ai = 0; ai < 2; ++ai)
#pragma unroll
                    for (int m = 0; m < 4; ++m) {
                        float* rp = O + (size_t)(u.row0 + ai * 128 + wr * 64 + m * 16 + fr) * 16 + 8 * fq;
                        *(f32x4*)rp = acc[ai][0][m][0]; *(f32x4*)(rp + 4) = acc[ai][0][m][1];
                    }
            }
        }
    }
};

template <class Sched>
__device__ __forceinline__ void gemm_phase(LAS unsigned char* lds, const int K, const Sched& S) {
    const EpiGen E;
    int tid_ = threadIdx.x; asm volatile("" : "+v"(tid_));
    const int tid = tid_, wid = __builtin_amdgcn_readfirstlane(tid >> 6), lane = tid & 63, wr = wid >> 2, wc = wid & 3, fr = lane & 15, fq = lane >> 4;
    const int nt = K / BK;
    unsigned voffA[2], voffB[2];
#pragma unroll
    for (int i = 0; i < 2; ++i) { int R, C; stage_rc(tid * 16 + i * 8192, R, C); voffA[i] = (unsigned)(R * K + C) * 2u; voffB[i] = (unsigned)(((R & ~31) + perm32(R & 31)) * K + C) * 2u; }
    const size_t kstep = (size_t)(BK * 2);
    const size_t hstep = (size_t)HALF * K * 2;
    const unsigned ldsw = (unsigned)wid * 1024u;
    const int aoff = lds_byte(wr * 64 + fr, fq * 8), boff = lds_byte(wc * 32 + fr, fq * 8);
#define PG8_SA(b, h) (((b) * 2 + (h)) * HTB)
#define PG8_SB(b, h) ((4 + (b) * 2 + (h)) * HTB)
#define PG8_STAGE(bufoff, gbase, voff) do { _Pragma("unroll") for (int _i = 0; _i < 2; ++_i) \
        __builtin_amdgcn_global_load_lds((const unsigned*)((const char*)(gbase) + (voff)[_i]), (LAS unsigned*)(lds + (bufoff) + ldsw + _i * 8192), 16, 0, 0); } while (0)
#define PG8_LDA(dst, b, h) do { _Pragma("unroll") for (int m = 0; m < 4; ++m) _Pragma("unroll") for (int k = 0; k < 2; ++k) dst[m][k] = *(const LAS bf16x8*)(lds + PG8_SA(b, h) + aoff + m * 2048 + k * 1024); } while (0)
#define PG8_LDB(dst, b, h) do { _Pragma("unroll") for (int n = 0; n < 2; ++n) _Pragma("unroll") for (int k = 0; k < 2; ++k) dst[n][k] = *(const LAS bf16x8*)(lds + PG8_SB(b, h) + boff + n * 2048 + k * 1024); } while (0)
#define PG8_MMA(ai, bj, At, Bt) do { __builtin_amdgcn_s_setprio(1); _Pragma("unroll") for (int m = 0; m < 4; ++m) _Pragma("unroll") for (int n = 0; n < 2; ++n) _Pragma("unroll") for (int k = 0; k < 2; ++k) \
        acc[ai][bj][m][n] = __builtin_amdgcn_mfma_f32_16x16x32_bf16(Bt[n][k], At[m][k], acc[ai][bj][m][n], 0, 0, 0); __builtin_amdgcn_s_setprio(0); } while (0)
#define PG8_WAIT_V(n) asm volatile("s_waitcnt vmcnt(" #n ")" ::: "memory")
#define PG8_WAIT_L(n) asm volatile("s_waitcnt lgkmcnt(" #n ")" ::: "memory")
#define PG8_BAR __builtin_amdgcn_s_barrier()
#define PG8_SCHED __builtin_amdgcn_sched_barrier(0)
    int ui = 0; bool staged = false; float* st_out = nullptr; int st_row0 = 0, st_col0 = 0;
    const char* cA; const char* cB;
    if (!S.tile(0, cA, cB)) return;
    f32x4 acc[2][2][4][2];
    S.init(0, acc, wr, wc, fr, fq);
    bf16x8 At[4][2], B0[2][2], B1[2][2];
    PG8_STAGE(PG8_SB(0, 0), cB, voffB); PG8_STAGE(PG8_SB(0, 1), cB + hstep, voffB); PG8_STAGE(PG8_SA(0, 0), cA, voffA); PG8_STAGE(PG8_SA(0, 1), cA + hstep, voffA);
    if (wr == 1) PG8_BAR;
    PG8_WAIT_V(2); PG8_BAR;
    PG8_STAGE(PG8_SB(1, 0), cB + kstep, voffB); PG8_STAGE(PG8_SA(1, 0), cA + kstep, voffA); PG8_STAGE(PG8_SB(1, 1), cB + hstep + kstep, voffB);
    PG8_WAIT_V(6); PG8_BAR;
    for (;;) {
        const char* nA = cA; const char* nB = cB;
        const bool has_next = S.tile(ui + 1, nA, nB);
        for (int t = 0; t < nt; t += 2) {
            const bool last = (t == nt - 2);
            const char* a1 = cA + (size_t)(t + 1) * kstep;
            const char* a2 = last ? nA : cA + (size_t)(t + 2) * kstep; const char* b2 = last ? nB : cB + (size_t)(t + 2) * kstep;
            const char* a3 = a2 + kstep; const char* b3 = b2 + kstep;
            PG8_LDB(B0, 0, 0); PG8_LDB(B1, 0, 1); PG8_SCHED; PG8_LDA(At, 0, 0); PG8_STAGE(PG8_SA(1, 1), a1 + hstep, voffA);
            PG8_WAIT_V(8); PG8_WAIT_L(0); PG8_BAR; PG8_MMA(0, 0, At, B0); PG8_MMA(0, 1, At, B1); PG8_BAR; PG8_SCHED;
            PG8_LDA(At, 0, 1); PG8_STAGE(PG8_SB(0, 0), b2, voffB); PG8_STAGE(PG8_SB(0, 1), b2 + hstep, voffB); PG8_STAGE(PG8_SA(0, 0), a2, voffA);
            PG8_WAIT_V(8); PG8_WAIT_L(0); PG8_BAR; PG8_MMA(1, 0, At, B0); PG8_MMA(1, 1, At, B1); PG8_BAR; PG8_SCHED;
            PG8_LDB(B0, 1, 0); PG8_LDB(B1, 1, 1); PG8_SCHED; PG8_LDA(At, 1, 0); PG8_STAGE(PG8_SA(0, 1), a2 + hstep, voffA);
            PG8_WAIT_V(8); PG8_WAIT_L(0); PG8_BAR; PG8_MMA(0, 0, At, B0); PG8_MMA(0, 1, At, B1); PG8_BAR; PG8_SCHED;
            PG8_LDA(At, 1, 1); PG8_STAGE(PG8_SB(1, 0), b3, voffB); PG8_STAGE(PG8_SB(1, 1), b3 + hstep, voffB); PG8_STAGE(PG8_SA(1, 0), a3, voffA);
            PG8_WAIT_V(8); PG8_WAIT_L(0); PG8_BAR; PG8_MMA(1, 0, At, B0); PG8_MMA(1, 1, At, B1); PG8_BAR; PG8_SCHED;
        }
        if (wr == 0) PG8_BAR;
        { Unit u; S.epi(ui, u);
          if (u.mode == 1 && !has_next) { staged = true; st_out = (float*)u.out; st_row0 = u.row0; st_col0 = u.col0; }
          else E(acc, u, wr, wc, fr, fq); }
        if (!has_next) break;
        S.init(ui + 1, acc, wr, wc, fr, fq);
        cA = nA; cB = nB; ++ui;
        if (wr == 1) PG8_BAR;
    }
    PG8_WAIT_V(0);
    PG8_BAR;
    if (staged) {
        LAS float* Sg = (LAS float*)lds;
        GAS bf16_t* O = (GAS bf16_t*)st_out;
#pragma unroll
        for (int ai = 0; ai < 2; ++ai) {
#pragma unroll
            for (int m = 0; m < 4; ++m)
#pragma unroll
                for (int bj = 0; bj < 2; ++bj)
#pragma unroll
                    for (int n = 0; n < 2; ++n) *(LAS f32x4*)(Sg + (wr * 64 + m * 16 + fr) * 260 + bj * 128 + wc * 32 + 8 * fq + 4 * n) = acc[ai][bj][m][n];
            __syncthreads();
#pragma unroll
            for (int r = 0; r < 16; ++r) {
                const int rl = wid * 16 + r;
                const f32x4 v = *(const LAS f32x4*)(Sg + rl * 260 + lane * 4);
                { u32x2 w; w.x = pk_f16(v[0], v[1]); w.y = pk_f16(v[2], v[3]); *(GAS u32x2*)(O + (size_t)(st_row0 + ai * 128 + rl) * 2048 + st_col0 + lane * 4) = w; }
            }
            __syncthreads();
        }
    }
#undef PG8_SA
#undef PG8_SB
#undef PG8_STAGE
#undef PG8_LDA
#undef PG8_LDB
#undef PG8_MMA
#undef PG8_WAIT_V
#undef PG8_WAIT_L
#undef PG8_BAR
#undef PG8_SCHED
}
}
using pg8::Unit;

struct SchedIn {
    const unsigned char* ws; int l, G, c;
    __device__ __forceinline__ bool tile(int i, const char*& a, const char*& b) const {
        int L = i * G + c; if (L >= 1008) return false;
        const char* h = (const char*)(ws + WS_H); const char* w = (const char*)(ws + WS_WIN) + (size_t)l * NWT * DM * 2;
        const size_t tstep = (size_t)256 * DM * 2; int pm, pn;
        if (L < 736) { pg8::tile_map(L, 32, 23, pm, pn); a = h + pm * tstep; b = (pn < 21) ? w + pn * tstep : w + (size_t)(6912 + (pn - 21) * 256) * DM * 2; }
        else if (L < 992) { pg8::tile_map(L - 736, 8, 32, pm, pn); a = w + (size_t)(5376 + pm * 256) * DM * 2; b = h + pn * tstep; }
        else {
            const int r = L - 992;
            const char* mn = (const char*)(ws + WS_MEMN) + (size_t)l * MEMTOK * DM * 2; const char* wk = (const char*)(ws + WS_WXKV) + (size_t)l * 1024 * DM * 2;
            if (r < 8) { pm = r >> 1; pn = r & 1; a = mn + pm * tstep; b = wk + pn * tstep; }
            else { const int r8 = r - 8; pm = r8 >> 2; pn = r8 & 3; a = wk + (size_t)(512 + pm * 256) * DM * 2; b = mn + pn * tstep; }
        }
        return true;
    }
    __device__ __forceinline__ void epi(int i, Unit& u) const {
        int L = i * G + c; int pm, pn;
        u.res = nullptr; u.mode = 0; u.act = 0; u.scale = 1.0f;
        if (L < 736) {
            pg8::tile_map(L, 32, 23, pm, pn); u.row0 = pm * 256;
            if (pn < 4)        { u.out = (void*)(ws + WS_Q); u.ld = 1024; u.col0 = pn * 256; u.scale = 0.08838834764831845f * 1.4426950408889634f; }
            else if (pn < 8)   { u.out = (void*)(ws + WS_K); u.ld = 1024; u.col0 = (pn - 4) * 256; }
            else if (pn < 16)  { u.out = (void*)(ws + WS_GATE); u.ld = 2048; u.col0 = (pn - 8) * 256; u.act = 1; }
            else if (pn == 16) { u.out = (void*)(ws + WS_GLAQ); u.ld = 256; u.col0 = 0; u.scale = 0.125f; }
            else if (pn == 17) { u.out = (void*)(ws + WS_GLAK); u.ld = 256; u.col0 = 0; }
            else if (pn < 20)  { u.out = (void*)(ws + WS_SGUU); u.ld = 512; u.col0 = (pn - 18) * 256; u.act = 2; }
            else if (pn == 20) { u.out = (void*)(ws + WS_GLAR); u.ld = 16; u.col0 = 0; u.mode = 2; }
            else               { u.out = (void*)(ws + WS_SGUV); u.ld = 512; u.col0 = (pn - 21) * 256; u.act = 2; }
        } else if (L < 992) {
            pg8::tile_map(L - 736, 8, 32, pm, pn);
            const int b = pn >> 3; u.col0 = (pn & 7) * 256; u.ld = 2048;
            if (pm < 4)      { u.out = (void*)(ws + WS_SBVT); u.row0 = b * 1024 + pm * 256; }
            else if (pm < 6) { u.out = (void*)(ws + WS_GLAVT); u.row0 = b * 512 + (pm - 4) * 256; }
            else             { u.out = (void*)(ws + WS_SGUVT); u.row0 = b * 512 + (pm - 6) * 256; u.act = 2; }
        } else {
            const int r = L - 992;
            if (r < 8) { pm = r >> 1; pn = r & 1; u.out = (void*)(ws + WS_KX + (size_t)l * MEMTOK * 512 * 2); u.row0 = pm * 256; u.col0 = pn * 256; u.ld = 512; }
            else { const int r8 = r - 8; pm = r8 >> 2; pn = r8 & 3;
                u.out = (void*)(ws + WS_VXT + (size_t)l * MEMTOK * 512 * 2); u.row0 = pn * 512 + pm * 256; u.col0 = 0; u.ld = 256; }
        }
    }
};
struct SchedOut {
    const unsigned char* ws; const float* xin; int l, G, c;
    __device__ __forceinline__ bool tile(int i, const char*& a, const char*& b) const {
        const int L = i * G + c; if (L >= 256) return false;
        int pm, pn; pg8::tile_map(L, 32, 8, pm, pn);
        const size_t tstep = (size_t)256 * DM * 2;
        a = (const char*)(ws + WS_MIX) + pm * tstep; b = (const char*)(ws + WS_WOUT) + (size_t)l * DM * DM * 2 + pn * tstep;
        return true;
    }
    __device__ __forceinline__ void epi(int i, Unit& u) const {
        const int L = i * G + c; int pm, pn; pg8::tile_map(L, 32, 8, pm, pn);
        u.out = (void*)(ws + WS_X); u.res = xin; u.row0 = pm * 256; u.col0 = pn * 256; u.ld = 2048; u.mode = 1; u.act = 0; u.scale = 1.0f;
    }
};
struct SchedXo {
    const unsigned char* ws; int l, G, c;
    __device__ __forceinline__ bool tile(int i, const char*& a, const char*& b) const {
        const int L = i * G + c; if (L >= 256) return false;
        int pm, pn; pg8::tile_map(L, 32, 8, pm, pn);
        const size_t tstep = (size_t)256 * 512 * 2;
        a = (const char*)(ws + WS_XO) + pm * tstep; b = (const char*)(ws + WS_WXO) + (size_t)l * DM * 512 * 2 + pn * tstep;
        return true;
    }
    __device__ __forceinline__ void epi(int i, Unit& u) const {
        const int L = i * G + c; int pm, pn; pg8::tile_map(L, 32, 8, pm, pn);
        u.out = (void*)(ws + WS_X); u.res = (const float*)(const void*)(ws + WS_X); u.row0 = pm * 256; u.col0 = pn * 256; u.ld = 2048; u.mode = 1; u.act = 0; u.scale = 1.0f;
    }
};

struct SchedAny {
    const unsigned char* ws; const float* xin; int l, G, c, kind;
    __device__ __forceinline__ bool tile(int i, const char*& a, const char*& b) const {
        if (kind == 0) { SchedIn S{ws, l, G, c}; return S.tile(i, a, b); }
        if (kind == 1) { SchedOut S{ws, xin, l, G, c}; return S.tile(i, a, b); }
        SchedXo S{ws, l, G, c}; return S.tile(i, a, b);
    }
    __device__ __forceinline__ void init(int i, f32x4 (&acc)[2][2][4][2], int wr, int wc, int fr, int fq) const {
        if (kind == 0) {
#pragma unroll
            for (int a = 0; a < 2; ++a)
#pragma unroll
                for (int b = 0; b < 2; ++b)
#pragma unroll
                    for (int m = 0; m < 4; ++m)
#pragma unroll
                        for (int n = 0; n < 2; ++n) acc[a][b][m][n] = (f32x4){0.f, 0.f, 0.f, 0.f};
        } else {
            const int L = i * G + c; if (L >= 256) return;
            int pm, pn; pg8::tile_map(L, 32, 8, pm, pn);
            if (kind == 1 && l == 0) {
                const GAS float* R = (const GAS float*)xin;
#pragma unroll
                for (int a = 0; a < 2; ++a)
#pragma unroll
                    for (int m = 0; m < 4; ++m) {
                        const size_t off = (size_t)(pm * 256 + a * 128 + wr * 64 + m * 16 + fr) * 2048 + pn * 256 + wc * 32 + 8 * fq;
#pragma unroll
                        for (int b = 0; b < 2; ++b)
#pragma unroll
                            for (int n = 0; n < 2; ++n) acc[a][b][m][n] = *(const GAS f32x4*)(R + off + b * 128 + n * 4);
                    }
            } else {
                const GAS bf16_t* R = (const GAS bf16_t*)(ws + WS_X);
#pragma unroll
                for (int a = 0; a < 2; ++a)
#pragma unroll
                    for (int m = 0; m < 4; ++m) {
                        const size_t off = (size_t)(pm * 256 + a * 128 + wr * 64 + m * 16 + fr) * 2048 + pn * 256 + wc * 32 + 8 * fq;
#pragma unroll
                        for (int b = 0; b < 2; ++b) {
                            const u32x4 w = *(const GAS u32x4*)(R + off + b * 128);
                            acc[a][b][m][0] = (f32x4){hflo(w.x), hfhi(w.x), hflo(w.y), hfhi(w.y)};
                            acc[a][b][m][1] = (f32x4){hflo(w.z), hfhi(w.z), hflo(w.w), hfhi(w.w)};
                        }
                    }
            }
        }
    }
    __device__ __forceinline__ void epi(int i, Unit& u) const {
        if (kind == 0) { SchedIn S{ws, l, G, c}; S.epi(i, u); }
        else if (kind == 1) { SchedOut S{ws, xin, l, G, c}; S.epi(i, u); }
        else { SchedXo S{ws, l, G, c}; S.epi(i, u); }
    }
};

template <bool F32OUT, bool SRCBF = false>
__device__ __forceinline__ void norm_rows(const GAS void* srcv, const float* g, GAS void* dst, int nrows, int gw, int nw, int lane) {
    for (int row0 = gw; row0 < nrows; row0 += 4 * nw) {
        f32x4 v[4][8], gv[8]; float ss[4];
#pragma unroll
        for (int q = 0; q < 4; ++q) {
            const int row = row0 + q * nw; const size_t ro = (size_t)(row < nrows ? row : row0) * DM;
            if (SRCBF) { const GAS u32x2* s2 = (const GAS u32x2*)((const GAS bf16_t*)srcv + ro);
#pragma unroll
                for (int i = 0; i < 8; ++i) { const u32x2 w = s2[lane + 64 * i]; v[q][i] = (f32x4){hflo(w.x), hfhi(w.x), hflo(w.y), hfhi(w.y)}; } }
            else { const GAS f32x4* s4 = (const GAS f32x4*)((const GAS float*)srcv + ro);
#pragma unroll
                for (int i = 0; i < 8; ++i) v[q][i] = s4[lane + 64 * i]; }
        }
#pragma unroll
        for (int i = 0; i < 8; ++i) gv[i] = ((const f32x4*)g)[lane + 64 * i];
#pragma unroll
        for (int q = 0; q < 4; ++q) {
            float a = 0.f;
#pragma unroll
            for (int i = 0; i < 8; ++i) a += v[q][i][0] * v[q][i][0] + v[q][i][1] * v[q][i][1] + v[q][i][2] * v[q][i][2] + v[q][i][3] * v[q][i][3];
            ss[q] = 1.0f / sqrtf(wave_sum(a) * (1.0f / DM) + EPS);
        }
#pragma unroll
        for (int q = 0; q < 4; ++q) {
            const int row = row0 + q * nw;
            if (row < nrows) {
#pragma unroll
                for (int i = 0; i < 8; ++i) {
                    const f32x4 y = v[q][i] * ss[q] * gv[i];
                    if (F32OUT) ((GAS f32x4*)((GAS float*)dst + (size_t)row * DM))[lane + 64 * i] = y;
                    else { u32x2 w; w.x = pk_bf16(y[0], y[1]); w.y = pk_bf16(y[2], y[3]); ((GAS u32x2*)((GAS bf16_t*)dst + (size_t)row * DM))[lane + 64 * i] = w; }
                }
            }
        }
    }
}

__device__ __forceinline__ int win_src_col(int n) {
    if (n < 2048) return n;
    if (n < 3072) return 3072 + (n - 2048);
    if (n < 3584) return 5136 + (n - 3072);
    if (n < 4096) return 6672 + (n - 3584);
    if (n < 4608) return n;
    if (n < 5120) return 5648 + (n - 4608);
    if (n < 5136) return n;
    if (n < 5376) return -1;
    if (n < 6400) return 2048 + (n - 5376);
    if (n < 6912) return 4608 + (n - 6400);
    return 6160 + (n - 6912);
}
struct TDesc { const float* src; GAS bf16_t* dst; const float* gain; int K, N, k0, n0; bool winmap, f16; };
__device__ __forceinline__ TDesc tdesc(const Params& p, int t) {
    constexpr int T_IN = 32 * 58, T_OUT = 32 * 16, T_XQ = 32 * 4, T_XKV = 32 * 8, T_XO = 8 * 16, T_L = T_IN + T_OUT + T_XQ + T_XKV + T_XO;
    unsigned char* ws = p.ws; TDesc d;
    const int l = t / T_L; int r = t - l * T_L;
    if (r < T_IN) { d.src = p.w_in + (size_t)l * DM * INW; d.dst = (GAS bf16_t*)(ws + WS_WIN) + (size_t)l * NWT * DM; d.K = DM; d.N = INW; d.k0 = (r & 31) * 64; d.n0 = (r >> 5) * 128; d.winmap = true; d.gain = nullptr; d.f16 = false; return d; }
    r -= T_IN; d.winmap = false; d.gain = nullptr; d.f16 = false;
    if (r < T_OUT) { d.src = p.w_out + (size_t)l * DM * DM; d.dst = (GAS bf16_t*)(ws + WS_WOUT) + (size_t)l * DM * DM; d.K = DM; d.N = DM; d.k0 = (r & 31) * 64; d.n0 = (r >> 5) * 128; return d; }
    r -= T_OUT;
    if (r < T_XQ) { d.src = p.w_xq + (size_t)l * DM * 512; d.dst = (GAS bf16_t*)(ws + WS_WXQ) + (size_t)l * 512 * DM; d.K = DM; d.N = 512; d.k0 = (r & 31) * 64; d.n0 = (r >> 5) * 128; d.gain = p.norm_xattn + (size_t)l * DM; d.f16 = true; return d; }
    r -= T_XQ;
    if (r < T_XKV) { d.src = p.w_xkv + (size_t)l * DM * 1024; d.dst = (GAS bf16_t*)(ws + WS_WXKV) + (size_t)l * 1024 * DM; d.K = DM; d.N = 1024; d.k0 = (r & 31) * 64; d.n0 = (r >> 5) * 128; return d; }
    r -= T_XKV;
    d.src = p.w_xo + (size_t)l * 512 * DM; d.dst = (GAS bf16_t*)(ws + WS_WXO) + (size_t)l * DM * 512; d.K = 512; d.N = DM; d.k0 = (r & 7) * 64; d.n0 = (r >> 3) * 128; return d;
}
__device__ __forceinline__ void tload(const TDesc& d, float (&v)[2][8], int tid) {
    const int nn = tid & 63, kq = tid >> 6;
#pragma unroll
    for (int h = 0; h < 2; ++h) {
        const int n = d.n0 + 64 * h + nn; const int sc = d.winmap ? win_src_col(n) : n;
        const float* sp = d.src + (size_t)(d.k0 + kq * 8) * d.N + (sc >= 0 ? sc : 0);
#pragma unroll
        for (int i = 0; i < 8; ++i) v[h][i] = sp[(size_t)i * d.N];
    }
}
__device__ void prologue(const Params& p, LAS unsigned char* lds, const int bid, const int nblk) {
    int tid_ = threadIdx.x; asm volatile("" : "+v"(tid_));
    const int tid = tid_, lane = tid & 63, wid = tid >> 6;
    unsigned char* ws = p.ws;
    LAS float* T = (LAS float*)lds;
    constexpr int T_ALL = DEPTH * (32 * 58 + 32 * 16 + 32 * 4 + 32 * 8 + 8 * 16);
    float v[2][8];
    int t = bid;
    if (t < T_ALL) { const TDesc d = tdesc(p, t); tload(d, v, tid); }
    for (; t < T_ALL; t += nblk) {
        const TDesc d = tdesc(p, t);
        __syncthreads();
        { const int nn = tid & 63, kq = tid >> 6;
          float gk[8];
#pragma unroll
          for (int i = 0; i < 8; ++i) gk[i] = d.gain ? d.gain[d.k0 + kq * 8 + i] : 1.0f;
#pragma unroll
          for (int h = 0; h < 2; ++h)
#pragma unroll
            for (int i = 0; i < 8; ++i) { const int n = d.n0 + 64 * h + nn; const bool pad = d.winmap && n >= 5136 && n < 5376; T[h * 4160 + (kq * 8 + i) * 65 + nn] = pad ? 0.0f : v[h][i] * gk[i]; } }
        __syncthreads();
        if (t + nblk < T_ALL) { const TDesc dn = tdesc(p, t + nblk); tload(dn, v, tid); }
        { const int n = tid >> 3, kc = tid & 7;
#pragma unroll
          for (int h = 0; h < 2; ++h) {
            float x[8];
#pragma unroll
            for (int e = 0; e < 8; ++e) x[e] = T[h * 4160 + (kc * 8 + e) * 65 + n];
            u32x4 w;
            if (d.f16) { w.x = pk_f16(x[0], x[1]); w.y = pk_f16(x[2], x[3]); w.z = pk_f16(x[4], x[5]); w.w = pk_f16(x[6], x[7]); }
            else { w.x = pk_bf16(x[0], x[1]); w.y = pk_bf16(x[2], x[3]); w.z = pk_bf16(x[4], x[5]); w.w = pk_bf16(x[6], x[7]); }
            *(u32x4*)(d.dst + (size_t)(d.n0 + 64 * h + n) * d.K + d.k0 + kc * 8) = w;
          } }
    }
    const int gw = bid * 8 + wid, nw = nblk * 8;
    for (int l = 0; l < DEPTH; ++l) norm_rows<false>((const GAS void*)p.mem, p.norm_mem + l * DM, (GAS bf16_t*)(ws + WS_MEMN) + (size_t)l * MEMTOK * DM, MEMTOK, gw, nw, lane);
    norm_rows<false>((const GAS void*)p.x, p.norm_mix, (GAS bf16_t*)(ws + WS_H), NTOK, gw, nw, lane);
}

__device__ __forceinline__ void finish_head(const Params& p, int l, const f32x4 (&o)[8], size_t tok, int colbase, int fq) {
    float ss = 0.f;
#pragma unroll
    for (int n = 0; n < 8; ++n) ss += o[n][0] * o[n][0] + o[n][1] * o[n][1] + o[n][2] * o[n][2] + o[n][3] * o[n][3];
    ss += __shfl_xor(ss, 16); ss += __shfl_xor(ss, 32);
    const float rstd = 1.0f / sqrtf(ss * (1.0f / 128.0f) + EPS);
    const float* gn = p.out_norm + (size_t)l * 2048 + colbase + 4 * fq;
    const GAS bf16_t* gt = (const GAS bf16_t*)(p.ws + WS_GATE) + tok * 2048 + colbase + 4 * fq;
    GAS bf16_t* mx = (GAS bf16_t*)(p.ws + WS_MIX) + tok * 2048 + colbase + 4 * fq;
    f32x4 gv[8]; u32x2 gtv[8];
#pragma unroll
    for (int n = 0; n < 8; ++n) { gv[n] = *(const f32x4*)(gn + 16 * n); gtv[n] = *(const u32x2*)(gt + 16 * n); }
#pragma unroll
    for (int n = 0; n < 8; ++n) {
        const f32x4 g = gv[n]; const u32x2 gg = gtv[n];
        const float y0 = bf2f(pk_bf16(o[n][0] * rstd * g[0], 0.f) & 0xffffu) * bflo(gg.x);
        const float y1 = bf2f(pk_bf16(o[n][1] * rstd * g[1], 0.f) & 0xffffu) * bfhi(gg.x);
        const float y2 = bf2f(pk_bf16(o[n][2] * rstd * g[2], 0.f) & 0xffffu) * bflo(gg.y);
        const float y3 = bf2f(pk_bf16(o[n][3] * rstd * g[3], 0.f) & 0xffffu) * bfhi(gg.y);
        u32x2 w; w.x = pk_bf16(y0, y1); w.y = pk_bf16(y2, y3);
        *(u32x2*)(mx + 16 * n) = w;
    }
}

template <bool DIAG>
__device__ __forceinline__ void sb_step(f32x4 (&o)[8], float& R, const LAS bf16_t* Qs, const LAS bf16_t* Ks, const LAS bf16_t* Vs, LAS bf16_t* Ps,
                                        const f16x8& U0, const f16x8& U16, int qloc, int fr, int fq) {
    f32x4 z[8];
#pragma unroll
    for (int n = 0; n < 8; ++n) z[n] = (f32x4){0.f, 0.f, 0.f, 0.f};
    __builtin_amdgcn_s_setprio(1);
#pragma unroll
    for (int kk = 0; kk < 4; ++kk) {
        const bf16x8 qa = *(const LAS bf16x8*)(Qs + fr * 136 + kk * 32 + fq * 8);
#pragma unroll
        for (int n = 0; n < 8; ++n) { const bf16x8 kf = *(const LAS bf16x8*)(Ks + (n * 16 + fr) * 136 + kk * 32 + fq * 8); z[n] = MFMA_BF16(kf, qa, z[n]); }
        __builtin_amdgcn_sched_barrier(0);
    }
    __builtin_amdgcn_s_setprio(0);
    float rs = 0.f;
#pragma unroll
    for (int n = 0; n < 8; ++n) {
        f16x4 hv;
#pragma unroll
        for (int r = 0; r < 4; ++r) {
            const float zz = z[n][r];
            float lk = -(fmaxf(zz, 0.0f) + __builtin_amdgcn_logf(1.0f + __builtin_amdgcn_exp2f(-fabsf(zz))));
            if (DIAG) lk = (n * 16 + 4 * fq + r < qloc) ? lk : 0.0f;
            z[n][r] = zz + lk;
            rs += lk; hv[r] = (_Float16)lk;
        }
        *(LAS f16x4*)(Ps + fr * 136 + n * 16 + 4 * fq) = hv;
    }
    rs += __shfl_xor(rs, 16); rs += __shfl_xor(rs, 32);
    LDS_FENCE();
    f16x8 ONES;
#pragma unroll
    for (int e = 0; e < 8; ++e) ONES[e] = (_Float16)1.0f;
#pragma unroll
    for (int kk = 0; kk < 4; ++kk) {
        const f16x8 pa = *(const LAS f16x8*)(Ps + fr * 136 + kk * 32 + fq * 8);
#pragma unroll
        for (int n = 0; n < 8; ++n) {
            const int dl = 32 * kk - 16 * n;
            if (dl >= 16) z[n] = MFMA_F16(ONES, pa, z[n]);
            else if (dl == 0) z[n] = MFMA_F16(U0, pa, z[n]);
            else if (dl == -16) z[n] = MFMA_F16(U16, pa, z[n]);
        }
    }
#pragma unroll
    for (int n = 0; n < 8; ++n) {
        float a[4];
#pragma unroll
        for (int r = 0; r < 4; ++r) {
            a[r] = __builtin_amdgcn_exp2f(z[n][r] + R);
            if (DIAG) a[r] = (n * 16 + 4 * fq + r < qloc) ? a[r] : 0.0f;
        }
        u32x2 w; w.x = pk_bf16(a[0], a[1]); w.y = pk_bf16(a[2], a[3]);
        *(LAS u32x2*)(Ps + fr * 136 + n * 16 + 4 * fq) = w;
    }
    R += rs;
    LDS_FENCE();
    __builtin_amdgcn_s_setprio(1);
#pragma unroll
    for (int kk = 0; kk < 4; ++kk) {
        const bf16x8 pa = *(const LAS bf16x8*)(Ps + fr * 136 + kk * 32 + fq * 8);
#pragma unroll
        for (int n = 0; n < 8; ++n) { const bf16x8 vf = *(const LAS bf16x8*)(Vs + (n * 16 + fr) * 136 + kk * 32 + fq * 8); o[n] = MFMA_BF16(vf, pa, o[n]); }
        __builtin_amdgcn_sched_barrier(0);
    }
    __builtin_amdgcn_s_setprio(0);
}
__device__ void sb_phase(const Params& p, int l, LAS unsigned char* lds, const int bid, const int nblk) {
    int tid_ = threadIdx.x; asm volatile("" : "+v"(tid_));
    const int tid = tid_, wid = __builtin_amdgcn_readfirstlane(tid >> 6), lane = tid & 63, fr = lane & 15, fq = lane >> 4;
    LAS bf16_t* Ks = (LAS bf16_t*)lds;
    LAS bf16_t* Vs = Ks + 128 * 136;
    LAS bf16_t* Ps = Vs + 128 * 136 + wid * 16 * 136;
    LAS bf16_t* Qs = Vs + 2 * 128 * 136 + wid * 16 * 136;
    const GAS bf16_t* qb = (const GAS bf16_t*)(p.ws + WS_Q); const GAS bf16_t* kb = (const GAS bf16_t*)(p.ws + WS_K); const GAS bf16_t* vt = (const GAS bf16_t*)(p.ws + WS_SBVT);
    f16x8 U0, U16;
#pragma unroll
    for (int e = 0; e < 8; ++e) { U0[e] = (8 * fq + e - fr > 0) ? (_Float16)1.0f : (_Float16)0.0f; U16[e] = (8 * fq + e - fr > 16) ? (_Float16)1.0f : (_Float16)0.0f; }
    const int lr = tid >> 4, lc = (tid & 15) * 8;
    for (int pr = bid; pr < 256; pr += nblk) {
        const int bh = pr >> 3, ip = pr & 7, b = bh >> 3, h = bh & 7;
        const GAS bf16_t* kbase = kb + ((size_t)b * SEQ + lr) * 1024 + h * 128 + lc;
        const GAS bf16_t* vbase = vt + ((size_t)(b * 8 + h) * 128 + lr) * SEQ + lc;
        for (int half = 0; half < 2; ++half) {
            const int qi = half ? 15 - ip : ip;
            const int qloc = wid * 16 + fr;
            const size_t tok = (size_t)b * SEQ + qi * 128 + qloc;
            u32x4 pk[4], pv[4];
#pragma unroll
            for (int i = 0; i < 4; ++i) { pk[i] = *(const u32x4*)(kbase + ((size_t)qi * 128 + 32 * i) * 1024); pv[i] = *(const u32x4*)(vbase + (size_t)(32 * i) * SEQ + qi * 128); }
#pragma unroll
            for (int kk = 0; kk < 4; ++kk) *(LAS bf16x8*)(Qs + fr * 136 + kk * 32 + fq * 8) = *(const bf16x8*)(qb + tok * 1024 + h * 128 + kk * 32 + fq * 8);
            f32x4 o[8];
#pragma unroll
            for (int n = 0; n < 8; ++n) o[n] = (f32x4){0.f, 0.f, 0.f, 0.f};
            float R = 0.f;
            for (int j = qi; j >= 0; --j) {
                __syncthreads();
#pragma unroll
                for (int i = 0; i < 4; ++i) { *(LAS u32x4*)(Ks + (lr + 32 * i) * 136 + lc) = pk[i]; *(LAS u32x4*)(Vs + (lr + 32 * i) * 136 + lc) = pv[i]; }
                __syncthreads();
                if (j > 0) {
#pragma unroll
                    for (int i = 0; i < 4; ++i) { pk[i] = *(const u32x4*)(kbase + ((size_t)(j - 1) * 128 + 32 * i) * 1024); pv[i] = *(const u32x4*)(vbase + (size_t)(32 * i) * SEQ + (j - 1) * 128); }
                }
                if (j == qi) sb_step<true>(o, R, Qs, Ks, Vs, Ps, U0, U16, qloc, fr, fq);
                else sb_step<false>(o, R, Qs, Ks, Vs, Ps, U0, U16, qloc, fr, fq);
            }
            finish_head(p, l, o, tok, h * 128, fq);
        }
    }
}

__device__ void gla_p1(const Params& p, int l, LAS unsigned char* lds, const int bid, const int nblk) {
    int tid_ = threadIdx.x; asm volatile("" : "+v"(tid_));
    const int tid = tid_, wid = __builtin_amdgcn_readfirstlane(tid >> 6), lane = tid & 63, fr = lane & 15, fq = lane >> 4;
    LAS bf16_t* qd = (LAS bf16_t*)lds;
    LAS bf16_t* ki = qd + 128 * 72;
    LAS bf16_t* kdT = ki + 128 * 72;
    LAS bf16_t* vT = kdT + 2 * 64 * 72;
    LAS bf16_t* Am = vT + 128 * 136;
    LAS float* gtot = (LAS float*)(Am + 128 * 72);
    LAS float* gr = gtot + 512;
    unsigned char* ws = p.ws;
    const GAS bf16_t* glaq = (const GAS bf16_t*)(ws + WS_GLAQ); const GAS bf16_t* glak = (const GAS bf16_t*)(ws + WS_GLAK); const GAS bf16_t* glavT = (const GAS bf16_t*)(ws + WS_GLAVT);
    const GAS float* glar = (const GAS float*)(ws + WS_GLAR);
    GAS bf16_t* qdg = (GAS bf16_t*)(ws + WS_QDG); GAS float* ointra = (GAS float*)(ws + WS_OINTRA); GAS float* kvt = (GAS float*)(ws + WS_KVT); GAS float* decay = (GAS float*)(ws + WS_DECAY);
    for (int it = bid; it < 256; it += nblk) {
        const int bh = it >> 4, cp = it & 15, b = bh >> 2, h = bh & 3;
        const size_t T0 = (size_t)b * SEQ + cp * 128;
        __syncthreads();
        { const f32x4 g4 = *(const f32x4*)(glar + T0 * 16 + tid * 4); *(LAS f32x4*)(gr + tid * 4) = g4; }
        load_tile<16, 128>(vT, 136, glavT + ((size_t)(b * 4 + h) * 128) * SEQ + cp * 128, SEQ, tid);
        const int d = tid & 63, tg = wid;
        float wu[16];
#pragma unroll
        for (int r = 0; r < 16; ++r) wu[r] = p.w_up[((size_t)l * 16 + r) * 256 + h * 64 + d];
        const float bias = p.b_gate[l * 256 + h * 64 + d];
        load_tile<8, 128>(qd, 72, glaq + T0 * 256 + h * 64, 256, tid);
        load_tile<8, 128>(ki, 72, glak + T0 * 256 + h * 64, 256, tid);
        __syncthreads();
        float cs[16]; float run = 0.f;
#pragma unroll
        for (int i = 0; i < 16; ++i) {
            const LAS f32x4* rr = (const LAS f32x4*)(gr + (tg * 16 + i) * 16);
            float lg = bias;
#pragma unroll
            for (int r4 = 0; r4 < 4; ++r4) { const f32x4 q4 = rr[r4]; lg += q4[0] * wu[4 * r4] + q4[1] * wu[4 * r4 + 1] + q4[2] * wu[4 * r4 + 2] + q4[3] * wu[4 * r4 + 3]; }
            run += -softplus_f(-lg) * (1.0f / 16.0f);
            cs[i] = run;
        }
        gtot[tg * 64 + d] = run;
        __syncthreads();
        const int c = tg >> 2; float off = 0.f, bl = 0.f;
#pragma unroll
        for (int g = 0; g < 4; ++g) { const float t = gtot[(c * 4 + g) * 64 + d]; bl += t; if (c * 4 + g < tg) off += t; }
#pragma unroll
        for (int i = 0; i < 16; ++i) {
            const int t = tg * 16 + i; const size_t tok = T0 + t;
            const float bc = cs[i] + off;
            const float q = bf2f(qd[t * 72 + d]), k = bf2f(ki[t * 72 + d]);
            const bf16_t qv = f2bf(q * __expf(bc));
            qd[t * 72 + d] = qv; qdg[tok * 256 + h * 64 + d] = qv;
            ki[t * 72 + d] = f2bf(k * __expf(-bc));
            kdT[(c * 64 + d) * 72 + (t & 63)] = f2bf(k * __expf(bl - bc));
        }
        if ((tg & 3) == 0) decay[((size_t)bh * 32 + cp * 2 + c) * 64 + d] = __expf(bl);
        __syncthreads();
        const int lr0 = (wid & 3) * 16, trw = c * 64 + lr0 + fr;
        f32x4 a4[4];
#pragma unroll
        for (int n = 0; n < 4; ++n) a4[n] = (f32x4){0.f, 0.f, 0.f, 0.f};
#pragma unroll
        for (int kk = 0; kk < 2; ++kk) {
            const bf16x8 qa = *(const LAS bf16x8*)(qd + trw * 72 + kk * 32 + fq * 8);
#pragma unroll
            for (int n = 0; n < 4; ++n) { const bf16x8 kf = *(const LAS bf16x8*)(ki + (c * 64 + n * 16 + fr) * 72 + kk * 32 + fq * 8); a4[n] = MFMA_BF16(kf, qa, a4[n]); }
        }
#pragma unroll
        for (int n = 0; n < 4; ++n) {
            float a[4];
#pragma unroll
            for (int r = 0; r < 4; ++r) a[r] = (n * 16 + 4 * fq + r <= lr0 + fr) ? a4[n][r] : 0.0f;
            u32x2 w; w.x = pk_bf16(a[0], a[1]); w.y = pk_bf16(a[2], a[3]);
            *(LAS u32x2*)(Am + trw * 72 + n * 16 + 4 * fq) = w;
        }
        LDS_FENCE();
        {
            f32x4 o[8];
#pragma unroll
            for (int n = 0; n < 8; ++n) o[n] = (f32x4){0.f, 0.f, 0.f, 0.f};
#pragma unroll
            for (int kk = 0; kk < 2; ++kk) {
                const bf16x8 pa = *(const LAS bf16x8*)(Am + trw * 72 + kk * 32 + fq * 8);
#pragma unroll
                for (int n = 0; n < 8; ++n) { const bf16x8 vf = *(const LAS bf16x8*)(vT + (n * 16 + fr) * 136 + c * 64 + kk * 32 + fq * 8); o[n] = MFMA_BF16(vf, pa, o[n]); }
            }
            GAS bf16_t* op = (GAS bf16_t*)ointra + (T0 + trw) * 512 + h * 128 + 4 * fq;
#pragma unroll
            for (int n = 0; n < 8; ++n) { u32x2 w; w.x = pk_f16(o[n][0], o[n][1]); w.y = pk_f16(o[n][2], o[n][3]); *(GAS u32x2*)(op + 16 * n) = w; }
        }
        {
            f32x4 kv[2][4];
#pragma unroll
            for (int mt = 0; mt < 2; ++mt)
#pragma unroll
                for (int n = 0; n < 4; ++n) kv[mt][n] = (f32x4){0.f, 0.f, 0.f, 0.f};
#pragma unroll
            for (int kk = 0; kk < 2; ++kk)
#pragma unroll
                for (int mt = 0; mt < 2; ++mt) {
                    const bf16x8 va = *(const LAS bf16x8*)(vT + ((wid & 3) * 32 + mt * 16 + fr) * 136 + c * 64 + kk * 32 + fq * 8);
#pragma unroll
                    for (int n = 0; n < 4; ++n) { const bf16x8 kf = *(const LAS bf16x8*)(kdT + (c * 64 + n * 16 + fr) * 72 + kk * 32 + fq * 8); kv[mt][n] = MFMA_BF16(kf, va, kv[mt][n]); }
                }
            GAS bf16_t* kp = (GAS bf16_t*)kvt + ((size_t)bh * 32 + cp * 2 + c) * 8192;
#pragma unroll
            for (int mt = 0; mt < 2; ++mt)
#pragma unroll
                for (int n = 0; n < 4; ++n) { u32x2 w; w.x = pk_f16(kv[mt][n][0], kv[mt][n][1]); w.y = pk_f16(kv[mt][n][2], kv[mt][n][3]); *(GAS u32x2*)(kp + ((wid & 3) * 32 + mt * 16 + fr) * 64 + n * 16 + 4 * fq) = w; }
        }
    }
}
__device__ void gla_scan(const Params& p, const int bid, const int nblk) {
    const GAS float* kvt = (const GAS float*)(p.ws + WS_KVT); const GAS float* decay = (const GAS float*)(p.ws + WS_DECAY); GAS bf16_t* sprev = (GAS bf16_t*)(p.ws + WS_SPREV);
    int tid_ = threadIdx.x; asm volatile("" : "+v"(tid_));
    for (int g = bid * 512 + tid_; g < 16 * 8192; g += nblk * 512) {
        const int bh = g >> 13, e = g & 8191, d = e & 63;
        float dc[32], kv[32];
#pragma unroll
        for (int n = 0; n < 32; ++n) { const size_t ci = (size_t)bh * 32 + n; dc[n] = decay[ci * 64 + d]; kv[n] = (float)((const GAS _Float16*)kvt)[ci * 8192 + e]; }
        float s = 0.f;
#pragma unroll
        for (int n = 0; n < 32; ++n) {
            const size_t ci = (size_t)bh * 32 + n;
            sprev[ci * 8192 + e] = f2bf(s);
            s = dc[n] * s + kv[n];
        }
    }
}
__device__ void gla_p3(const Params& p, int l, LAS unsigned char* lds, const int bid, const int nblk) {
    int tid_ = threadIdx.x; asm volatile("" : "+v"(tid_));
    const int tid = tid_, wid = __builtin_amdgcn_readfirstlane(tid >> 6), lane = tid & 63, fr = lane & 15, fq = lane >> 4;
    LAS bf16_t* qd = (LAS bf16_t*)lds;
    LAS bf16_t* sp = qd + 128 * 72;
    const GAS bf16_t* qdg = (const GAS bf16_t*)(p.ws + WS_QDG); const GAS bf16_t* sprev = (const GAS bf16_t*)(p.ws + WS_SPREV); const GAS float* ointra = (const GAS float*)(p.ws + WS_OINTRA);
    for (int it = bid; it < 256; it += nblk) {
        const int bh = it >> 4, cp = it & 15, b = bh >> 2, h = bh & 3;
        const size_t T0 = (size_t)b * SEQ + cp * 128;
        __syncthreads();
        load_tile<8, 128>(qd, 72, qdg + T0 * 256 + h * 64, 256, tid);
        load_tile<8, 256>(sp, 72, sprev + ((size_t)bh * 32 + cp * 2) * 8192, 64, tid);
        __syncthreads();
        const int c = wid >> 2, trw = c * 64 + (wid & 3) * 16 + fr;
        f32x4 o[8];
        const GAS bf16_t* op = (const GAS bf16_t*)ointra + (T0 + trw) * 512 + h * 128 + 4 * fq;
#pragma unroll
        for (int n = 0; n < 8; ++n) { const u32x2 w = *(const GAS u32x2*)(op + 16 * n); o[n] = (f32x4){hflo(w.x), hfhi(w.x), hflo(w.y), hfhi(w.y)}; }
        __builtin_amdgcn_s_setprio(1);
#pragma unroll
        for (int kk = 0; kk < 2; ++kk) {
            const bf16x8 qa = *(const LAS bf16x8*)(qd + trw * 72 + kk * 32 + fq * 8);
#pragma unroll
            for (int n = 0; n < 8; ++n) { const bf16x8 sf = *(const LAS bf16x8*)(sp + (c * 128 + n * 16 + fr) * 72 + kk * 32 + fq * 8); o[n] = MFMA_BF16(sf, qa, o[n]); }
        }
        __builtin_amdgcn_s_setprio(0);
        finish_head(p, l, o, T0 + trw, 1024 + h * 128, fq);
    }
}

__device__ void sgu_phase(const Params& p, int l, LAS unsigned char* lds, const int bid, const int nblk) {
    int tid_ = threadIdx.x; asm volatile("" : "+v"(tid_));
    const int tid = tid_, wid = __builtin_amdgcn_readfirstlane(tid >> 6), lane = tid & 63, fr = lane & 15, fq = lane >> 4;
    LAS bf16_t* Wt = (LAS bf16_t*)lds;
    LAS bf16_t* Vt = Wt + 128 * 136;
    LAS float* rstd = (LAS float*)(Vt + 128 * 136);
    const GAS bf16_t* vT = (const GAS bf16_t*)(p.ws + WS_SGUVT); const GAS bf16_t* vr = (const GAS bf16_t*)(p.ws + WS_SGUV); const GAS bf16_t* uu = (const GAS bf16_t*)(p.ws + WS_SGUU);
    for (int it = bid; it < 256; it += nblk) {
        const int g = it & 3, bn = it >> 2, b = bn >> 4, n_ = bn & 15;
        const size_t T0 = (size_t)b * SEQ + n_ * 128;
        __syncthreads();
        {
            u32x4 rv[16];
#pragma unroll
            for (int i = 0; i < 16; ++i) rv[i] = *(const u32x4*)(vr + (T0 + wid * 16 + i) * 512 + lane * 8);
#pragma unroll
            for (int i = 0; i < 16; ++i) {
                float a = 0.f;
#pragma unroll
                for (int e = 0; e < 4; ++e) { const float x0 = bflo(rv[i][e]), x1 = bfhi(rv[i][e]); a += x0 * x0 + x1 * x1; }
                a = wave_sum(a);
                if (lane == 0) rstd[wid * 16 + i] = 1.0f / sqrtf(a * (1.0f / 512.0f) + EPS);
            }
        }
        load_tile<16, 128>(Vt, 136, vT + ((size_t)b * 512 + g * 128) * SEQ + n_ * 128, SEQ, tid);
        __syncthreads();
        {
            const f32x4* wsg = (const f32x4*)(p.w_sgu + ((size_t)l * 4 + g) * 16384);
#pragma unroll
            for (int i = 0; i < 8; ++i) {
                const int e4 = tid + 512 * i, t = e4 >> 5, s0 = (e4 & 31) * 4;
                const f32x4 w = wsg[e4]; const f32x4 r4 = *(const LAS f32x4*)(rstd + s0);
                u32x2 o2; o2.x = pk_bf16(s0 <= t ? w[0] * r4[0] : 0.f, s0 + 1 <= t ? w[1] * r4[1] : 0.f); o2.y = pk_bf16(s0 + 2 <= t ? w[2] * r4[2] : 0.f, s0 + 3 <= t ? w[3] * r4[3] : 0.f);
                *(LAS u32x2*)(Wt + t * 136 + s0) = o2;
            }
        }
        __syncthreads();
        f32x4 o[8];
#pragma unroll
        for (int n = 0; n < 8; ++n) o[n] = (f32x4){0.f, 0.f, 0.f, 0.f};
        const int t = wid * 16 + fr;
        __builtin_amdgcn_s_setprio(1);
#pragma unroll
        for (int kk = 0; kk < 4; ++kk) {
            const bf16x8 wa = *(const LAS bf16x8*)(Wt + t * 136 + kk * 32 + fq * 8);
#pragma unroll
            for (int n = 0; n < 8; ++n) { const bf16x8 vf = *(const LAS bf16x8*)(Vt + (n * 16 + fr) * 136 + kk * 32 + fq * 8); o[n] = MFMA_BF16(vf, wa, o[n]); }
        }
        __builtin_amdgcn_s_setprio(0);
        const float bs = p.b_sgu[((size_t)l * 4 + g) * 128 + t];
        const float* gn = p.sgu_norm + (size_t)l * 512 + g * 128 + 4 * fq;
        const GAS bf16_t* up = uu + (T0 + t) * 512 + g * 128 + 4 * fq;
#pragma unroll
        for (int n = 0; n < 8; ++n) {
            const f32x4 gg = *(const f32x4*)(gn + 16 * n); const u32x2 u2 = *(const u32x2*)(up + 16 * n);
            o[n][0] = bflo(u2.x) * (o[n][0] * gg[0] + bs); o[n][1] = bfhi(u2.x) * (o[n][1] * gg[1] + bs);
            o[n][2] = bflo(u2.y) * (o[n][2] * gg[2] + bs); o[n][3] = bfhi(u2.y) * (o[n][3] * gg[3] + bs);
        }
        finish_head(p, l, o, T0 + t, 1536 + g * 128, fq);
    }
}

#define XA_BAR() do { asm volatile("s_waitcnt lgkmcnt(0)" ::: "memory"); __builtin_amdgcn_s_barrier(); asm volatile("" ::: "memory"); } while (0)
__device__ void xattn_phase(const Params& p, int l, LAS unsigned char* lds, const int bid, const int nblk) {
    int tid_ = threadIdx.x; asm volatile("" : "+v"(tid_));
    const int tid = tid_, wid = __builtin_amdgcn_readfirstlane(tid >> 6), lane = tid & 63, fr = lane & 15, fq = lane >> 4;
    LAS bf16_t* KV = (LAS bf16_t*)lds;
    LAS bf16_t* Ps = KV + 256 * 136 + wid * 16 * 264;
    LAS bf16_t* St = KV;
    LAS float* rs = (LAS float*)(lds + 4 * 128 * 136 * 2);
    const GAS bf16_t* xb = (const GAS bf16_t*)(p.ws + WS_X);
    const GAS bf16_t* wq = (const GAS bf16_t*)(p.ws + WS_WXQ) + (size_t)l * 512 * DM;
    const GAS bf16_t* kx = (const GAS bf16_t*)(p.ws + WS_KX) + (size_t)l * MEMTOK * 512;
    const GAS bf16_t* vx = (const GAS bf16_t*)(p.ws + WS_VXT) + (size_t)l * MEMTOK * 512; GAS bf16_t* xo = (GAS bf16_t*)(p.ws + WS_XO);
    const int br = tid >> 4, bc = (tid & 15) * 8;
    for (int it = bid; it < 256; it += nblk) {
        const int qt = it & 15, bh = it >> 4, b = bh >> 2, h = bh & 3;
        const size_t T0 = (size_t)b * SEQ + qt * 128;
        const GAS bf16_t* xa = xb + (T0 + br) * DM + bc; const GAS bf16_t* wb = wq + ((size_t)h * 128 + br) * DM + bc;
        u32x4 sa[3][4], sb[3][4]; float ssq[4] = {0.f, 0.f, 0.f, 0.f};
#define XA_LOAD(set, ks) do { _Pragma("unroll") for (int j = 0; j < 4; ++j) { sa[set][j] = *(const u32x4*)(xa + (size_t)(32 * j) * DM + (ks) * 128); sb[set][j] = *(const u32x4*)(wb + (size_t)(32 * j) * DM + (ks) * 128); } } while (0)
#define XA_WRITE(set, buf) do { LAS bf16_t* A_ = St + (buf) * (2 * 128 * 136); _Pragma("unroll") for (int j = 0; j < 4; ++j) { const u32x4 x_ = sa[set][j]; \
            _Pragma("unroll") for (int e = 0; e < 4; ++e) { const float lo_ = hflo(x_[e]), hi_ = hfhi(x_[e]); ssq[j] += lo_ * lo_ + hi_ * hi_; } \
            *(LAS u32x4*)(A_ + (br + 32 * j) * 136 + bc) = x_; *(LAS u32x4*)(A_ + 128 * 136 + (br + 32 * j) * 136 + bc) = sb[set][j]; } } while (0)
        __syncthreads();
        XA_LOAD(0, 0); XA_LOAD(1, 1); XA_LOAD(2, 2);
        __builtin_amdgcn_sched_barrier(0);
        XA_WRITE(0, 0); __builtin_amdgcn_sched_barrier(0); XA_LOAD(0, 3);
        __builtin_amdgcn_sched_barrier(0);
        f32x4 acc[8];
#pragma unroll
        for (int n = 0; n < 8; ++n) acc[n] = (f32x4){0.f, 0.f, 0.f, 0.f};
        for (int k3 = 0; k3 < 18; k3 += 3) {
#pragma unroll
          for (int i = 0; i < 3; ++i) {
            const int ks = k3 + i;
            if (ks < 16) {
              XA_BAR();
              __builtin_amdgcn_s_setprio(1);
              { const LAS bf16_t* A_ = St + (ks & 1) * (2 * 128 * 136); const LAS bf16_t* B_ = A_ + 128 * 136;
#pragma unroll
                for (int kk = 0; kk < 4; ++kk) {
                  const f16x8 af = *(const LAS f16x8*)(A_ + (wid * 16 + fr) * 136 + kk * 32 + fq * 8);
#pragma unroll
                  for (int n = 0; n < 8; ++n) { const f16x8 bf = *(const LAS f16x8*)(B_ + (n * 16 + fr) * 136 + kk * 32 + fq * 8); acc[n] = MFMA_F16(bf, af, acc[n]); }
                  __builtin_amdgcn_sched_barrier(0);
                } }
              __builtin_amdgcn_s_setprio(0);
              if (ks + 1 < 16) { XA_WRITE((i + 1) % 3, (ks + 1) & 1); __builtin_amdgcn_sched_barrier(0); if (ks + 4 < 16) XA_LOAD((i + 1) % 3, ks + 4); }
              __builtin_amdgcn_sched_barrier(0);
            }
          }
        }
#pragma unroll
        for (int j = 0; j < 4; ++j) {
            float a = ssq[j];
            a += __shfl_xor(a, 1); a += __shfl_xor(a, 2); a += __shfl_xor(a, 4); a += __shfl_xor(a, 8);
            if ((tid & 15) == 0) rs[br + 32 * j] = 1.0f / sqrtf(a * (1.0f / DM) + EPS);
        }
        __syncthreads();
        {
            const float sc = rs[wid * 16 + fr] * 0.08838834764831845f;
#pragma unroll
            for (int n = 0; n < 8; ++n) { u32x2 w; w.x = pk_bf16(acc[n][0] * sc, acc[n][1] * sc); w.y = pk_bf16(acc[n][2] * sc, acc[n][3] * sc); *(LAS u32x2*)(St + (wid * 16 + fr) * 136 + n * 16 + 4 * fq) = w; }
        }
        LDS_FENCE();
        bf16x8 aq[4];
#pragma unroll
        for (int kk = 0; kk < 4; ++kk) aq[kk] = *(const LAS bf16x8*)(St + (wid * 16 + fr) * 136 + kk * 32 + fq * 8);
        __syncthreads();
        { int tk = tid; asm volatile("" : "+v"(tk));
          load_tile<16, 256>(KV, 136, kx + ((size_t)b * 256) * 512 + h * 128, 512, tk); }
        __syncthreads();
        __builtin_amdgcn_s_setprio(1);
        f32x4 sc[16];
#pragma unroll
        for (int n = 0; n < 16; ++n) sc[n] = (f32x4){0.f, 0.f, 0.f, 0.f};
#pragma unroll
        for (int kk = 0; kk < 4; ++kk)
#pragma unroll
            for (int n = 0; n < 16; ++n) { const bf16x8 kf = *(const LAS bf16x8*)(KV + (n * 16 + fr) * 136 + kk * 32 + fq * 8); sc[n] = MFMA_BF16(kf, aq[kk], sc[n]); }
        __builtin_amdgcn_s_setprio(0);
        float mx = -3.0e38f;
#pragma unroll
        for (int n = 0; n < 16; ++n) mx = fmaxf(mx, fmaxf(fmaxf(sc[n][0], sc[n][1]), fmaxf(sc[n][2], sc[n][3])));
        mx = fmaxf(mx, __shfl_xor(mx, 16)); mx = fmaxf(mx, __shfl_xor(mx, 32));
        float sm = 0.f;
#pragma unroll
        for (int n = 0; n < 16; ++n) {
#pragma unroll
            for (int r = 0; r < 4; ++r) { sc[n][r] = __expf(sc[n][r] - mx); sm += sc[n][r]; }
        }
        sm += __shfl_xor(sm, 16); sm += __shfl_xor(sm, 32);
        const float inv = 1.0f / sm;
#pragma unroll
        for (int n = 0; n < 16; ++n) {
            u32x2 w; w.x = pk_bf16(sc[n][0] * inv, sc[n][1] * inv); w.y = pk_bf16(sc[n][2] * inv, sc[n][3] * inv);
            *(LAS u32x2*)(Ps + fr * 264 + n * 16 + 4 * fq) = w;
        }
        __syncthreads();
        { int tk = tid; asm volatile("" : "+v"(tk));
          load_tile<32, 128>(KV, 264, vx + ((size_t)(b * 4 + h) * 128) * 256, 256, tk); }
        __syncthreads();
        __builtin_amdgcn_s_setprio(1);
        f32x4 o[8];
#pragma unroll
        for (int n = 0; n < 8; ++n) o[n] = (f32x4){0.f, 0.f, 0.f, 0.f};
#pragma unroll
        for (int kk = 0; kk < 8; ++kk) {
            const bf16x8 pf = *(const LAS bf16x8*)(Ps + fr * 264 + kk * 32 + fq * 8);
#pragma unroll
            for (int n = 0; n < 8; ++n) { const bf16x8 vf = *(const LAS bf16x8*)(KV + (n * 16 + fr) * 264 + kk * 32 + fq * 8); o[n] = MFMA_BF16(vf, pf, o[n]); }
        }
        __builtin_amdgcn_s_setprio(0);
        GAS bf16_t* op = xo + (T0 + wid * 16 + fr) * 512 + h * 128 + 4 * fq;
#pragma unroll
        for (int n = 0; n < 8; ++n) { u32x2 w; w.x = pk_bf16(o[n][0], o[n][1]); w.y = pk_bf16(o[n][2], o[n][3]); *(u32x2*)(op + 16 * n) = w; }
#undef XA_LOAD
#undef XA_WRITE
    }
}

#define XB_TMO      128
#define XB_XCNT(j)  (256  + 64 * (j))
#define XB_XSUB(j)  (1280 + 64 * (j))
#define XB_XGEN(j)  (2304 + 64 * (j))
#define XB_TOP      3328
#define XB_TOPGEN   3392
#define XCD_BAR_WORDS 3456
#define XB_SPIN_CAP (1u << 18)
__device__ __forceinline__ unsigned xb_ld(unsigned* p)              { return __hip_atomic_load(p, __ATOMIC_RELAXED, __HIP_MEMORY_SCOPE_AGENT); }
__device__ __forceinline__ unsigned xb_add(unsigned* p, unsigned v) { return __hip_atomic_fetch_add(p, v, __ATOMIC_RELAXED, __HIP_MEMORY_SCOPE_AGENT); }
__device__ __forceinline__ unsigned xb_xcc_id() { return (unsigned)__builtin_amdgcn_s_getreg((3 << 11) | 20) & 0xFu; }
#define XB_SPIN(cond, bar) do { unsigned _sp = 0; while (cond) { __builtin_amdgcn_s_sleep(1); \
    if ((++_sp & 255u) == 0u) { if (xb_ld(&(bar)[XB_TMO])) break; if (_sp > XB_SPIN_CAP) { atomicAdd(&(bar)[XB_TMO], 1u); break; } } } } while (0)
struct XcdBarrier { unsigned* bar; unsigned x; volatile LAS unsigned* st; };
__device__ __forceinline__ XcdBarrier xcd_barrier_post(unsigned* bar, volatile LAS unsigned* st) {
    XcdBarrier b; b.bar = bar; b.x = xb_xcc_id(); b.st = st;
    if (threadIdx.x == 0) (void)xb_add(&bar[XB_XCNT(b.x)], 1u);
    return b;
}
__device__ __forceinline__ void xcd_barrier_complete(unsigned* bar, unsigned x, unsigned& nloc, unsigned& nx) {
    const unsigned G = gridDim.x * gridDim.y * gridDim.z;
    unsigned sum, cnt, mine, sp = 0u;
    for (;;) {
        sum = 0u; cnt = 0u; mine = 0u;
#pragma unroll 1
        for (unsigned j = 0; j < 16; ++j) { const unsigned c = xb_ld(&bar[XB_XCNT(j)]); sum += c; cnt += (c > 0u) ? 1u : 0u; mine = (j == x) ? c : mine; }
        if (sum == G) break;
        __builtin_amdgcn_s_sleep(1);
        if ((++sp & 255u) == 0u) { if (xb_ld(&bar[XB_TMO])) break; if (sp > XB_SPIN_CAP) { atomicAdd(&bar[XB_TMO], 1u); break; } }
    }
    nloc = mine > 0u ? mine : 1u; nx = cnt > 0u ? cnt : 1u;
}
__device__ __forceinline__ void xcd_barrier(const XcdBarrier& b) {
    asm volatile("s_waitcnt vmcnt(0)" ::: "memory");
    __syncthreads();
    if (threadIdx.x == 0) {
        unsigned* bar = b.bar; unsigned bx_ = b.x; asm volatile("" : "+s"(bar), "+s"(bx_));
        __builtin_amdgcn_s_waitcnt(0);
        unsigned nloc = b.st[0], nx = b.st[1];
        if (nloc == 0u) { xcd_barrier_complete(bar, bx_, nloc, nx); b.st[0] = nloc; b.st[1] = nx; }
        const unsigned old = xb_add(&bar[XB_XSUB(bx_)], 1u);
        const unsigned gen = old / nloc;
        if (old + 1u == (gen + 1u) * nloc) {
            __builtin_amdgcn_fence(__ATOMIC_RELEASE, "agent");
            asm volatile("s_waitcnt vmcnt(0)" ::: "memory");
            const unsigned og = xb_add(&bar[XB_TOP], 1u);
            const unsigned tg = og / nx;
            if (og + 1u == (tg + 1u) * nx) xb_add(&bar[XB_TOPGEN], 1u);
            else XB_SPIN(xb_ld(&bar[XB_TOPGEN]) == tg, bar);
            __builtin_amdgcn_fence(__ATOMIC_ACQUIRE, "agent");
            xb_add(&bar[XB_XGEN(bx_)], 1u);
            asm volatile("s_waitcnt vmcnt(0)" ::: "memory");
        } else {
            XB_SPIN(xb_ld(&bar[XB_XGEN(bx_)]) == gen, bar);
            __builtin_amdgcn_fence(__ATOMIC_ACQUIRE, "agent");
            asm volatile("s_waitcnt vmcnt(0)" ::: "memory");
        }
    }
    __syncthreads();
}

constexpr int PPL = 8;
constexpr int N_PHASES = 1 + DEPTH * PPL;
__device__ __forceinline__ void phase_run(const Params& p0, int ph, LAS unsigned char* lds0) {
    int tid_ = threadIdx.x; asm volatile("" : "+v"(tid_));
    const int tid = tid_, lane = tid & 63, wid = tid >> 6;
    int G_ = gridDim.x, c_ = blockIdx.x; asm volatile("" : "+s"(G_), "+s"(c_));
    const int G = G_, c = c_;
    const int gw = c * 8 + wid, nw = G * 8;
    LAS unsigned char* lds = lds0; asm volatile("" : "+s"(lds));
#if defined(__HIP_DEVICE_COMPILE__)
    const __attribute__((address_space(4))) Params* kp = (const __attribute__((address_space(4))) Params*)__builtin_amdgcn_kernarg_segment_ptr(); asm volatile("" : "+s"(kp));
#define LOADP() Params p = *kp; { unsigned char* w_ = p.ws; asm volatile("" : "+s"(w_)); p.ws = w_; } unsigned char* ws = p.ws; (void)ws
#else
#define LOADP() Params p = p0; unsigned char* ws = p.ws; (void)ws
#endif
    __syncthreads();
#ifdef ONLY
    if (ph != 0 && ((ph - 1) % PPL) != ONLY) return;
    if (ph == 0 && ONLY != 10) return;
#endif
    if (ph == 0) { LOADP(); prologue(p, lds, c, G); return; }
    const int l = (ph - 1) / PPL, s = (ph - 1) % PPL;
    if (s == 0 || s == 4 || s == 6) {
        LOADP();
        SchedAny S{ws, (l == 0) ? p.x : (const float*)(const void*)(ws + WS_X), l, G, c, s == 0 ? 0 : (s == 4 ? 1 : 3)};
        pg8::gemm_phase(lds, s == 6 ? 512 : DM, S);
        return;
    }
    switch (s) {
    case 1: { LOADP(); gla_p1(p, l, lds, c, G); sgu_phase(p, l, lds, c, G); } break;
    case 2: { LOADP(); gla_scan(p, c, G); sb_phase(p, l, lds, c, G); } break;
    case 3: { LOADP(); gla_p3(p, l, lds, c, G); } break;
    case 5: { LOADP(); xattn_phase(p, l, lds, c, G); } break;
    default: { LOADP();
        if (l < DEPTH - 1) norm_rows<false, true>((const GAS void*)(ws + WS_X), p.norm_mix + (l + 1) * DM, (GAS bf16_t*)(ws + WS_H), NTOK, gw, nw, lane);
        else norm_rows<true, true>((const GAS void*)(ws + WS_X), p.final_norm, (GAS void*)p.out, NTOK, gw, nw, lane); }
        break;
    }
#undef LOADP
}

__global__ void __launch_bounds__(512, 2) fwd_kernel(Params p) {
    extern __shared__ __attribute__((aligned(16))) unsigned char lds_raw[];
    LAS unsigned char* lds = (LAS unsigned char*)lds_raw;
#if MEGA
    if (p.ph_hi < 0) cg::this_grid().sync();
    volatile LAS unsigned* st = (volatile LAS unsigned*)(lds + LDS_BYTES - 16);
    if (threadIdx.x == 0) { st[0] = 0u; st[1] = 0u; st[2] = 0u; st[3] = 0u; }
    __syncthreads();
    const XcdBarrier bar = xcd_barrier_post((unsigned*)(p.ws + WS_BAR), st);
    for (int ph = p.ph_lo; ph < p.ph_hi; ++ph) {
        phase_run(p, ph, lds);
#ifdef PROBE_DUP
        if ((PROBE_DUP == 10 && ph == 0) || (ph > 0 && (ph - 1) % PPL == PROBE_DUP)) { xcd_barrier(bar); phase_run(p, ph, lds); }
#endif
        if (ph + 1 < p.ph_hi) xcd_barrier(bar);
    }
#else
    for (int ph = p.ph_lo; ph < p.ph_hi; ++ph) phase_run(p, ph, lds);
#endif
}

extern "C" void kernel_launch(void* const* d_in, const int* in_sizes, int n_in, void* d_out, int out_size, void* d_ws, size_t ws_size, hipStream_t stream) {
    static int grid = 0;
    if (grid == 0) {
        if (n_in != 17 || ws_size < WS_END) { fprintf(stderr, "kernel_launch: unexpected problem (n_in %d, ws %zu < %zu)\n", n_in, ws_size, (size_t)WS_END); grid = -1; return; }
        int dev = 0, cus = 0, per_cu = 0;
        hipGetDevice(&dev); hipDeviceGetAttribute(&cus, hipDeviceAttributeMultiprocessorCount, dev);
        if (hipFuncSetAttribute((const void*)fwd_kernel, hipFuncAttributeMaxDynamicSharedMemorySize, LDS_BYTES) != hipSuccess) { fprintf(stderr, "kernel_launch: hipFuncSetAttribute failed\n"); grid = -1; return; }
        if (hipOccupancyMaxActiveBlocksPerMultiprocessor(&per_cu, (const void*)fwd_kernel, 512, LDS_BYTES) != hipSuccess || per_cu < 1) { fprintf(stderr, "kernel_launch: occupancy query gave %d\n", per_cu); per_cu = 1; }
        (void)hipGetLastError();
        grid = cus * 1;
        if (grid <= 0) grid = 256;
    }
    if (grid < 0) return;
    Params p{};
    p.x = (const float*)d_in[0]; p.mem = (const float*)d_in[1]; p.norm_mix = (const float*)d_in[2]; p.w_in = (const float*)d_in[3];
    p.w_up = (const float*)d_in[4]; p.b_gate = (const float*)d_in[5]; p.sgu_norm = (const float*)d_in[6]; p.w_sgu = (const float*)d_in[7];
    p.b_sgu = (const float*)d_in[8]; p.out_norm = (const float*)d_in[9]; p.w_out = (const float*)d_in[10]; p.norm_xattn = (const float*)d_in[11];
    p.norm_mem = (const float*)d_in[12]; p.w_xq = (const float*)d_in[13]; p.w_xkv = (const float*)d_in[14]; p.w_xo = (const float*)d_in[15];
    p.final_norm = (const float*)d_in[16];
    p.out = (float*)d_out; p.ws = (unsigned char*)d_ws;
#if MEGA
    p.ph_lo = 0; p.ph_hi = N_PHASES;
    if (hipMemsetAsync((char*)d_ws + WS_BAR, 0, 16384, stream) != hipSuccess) { fprintf(stderr, "kernel_launch: memset of the barrier words failed\n"); return; }
    void* args[] = {&p};
    hipError_t e = hipLaunchCooperativeKernel((const void*)fwd_kernel, dim3(grid), dim3(512), args, LDS_BYTES, stream);
    if (e != hipSuccess) fprintf(stderr, "cooperative launch failed: %s (grid %d)\n", hipGetErrorString(e), grid);
#else
    for (int ph = 0; ph < N_PHASES; ++ph) {
        p.ph_lo = ph; p.ph_hi = ph + 1;
        hipLaunchKernelGGL(fwd_kernel, dim3(grid), dim3(512), LDS_BYTES, stream, p);
    }
#endif
}
```
